# Optimizing an MI355X kernel written in HIP

```python
import jax, jax.numpy as jnp
from jax import lax
import numpy as np

D_MODEL = 1024
BATCH = 1
SEQ = 16384
DEPTH = 1

PLE_DIM = 256
RWKV_WIDTH = 512
RWKV_HEAD = 64
RWKV_HEADS = RWKV_WIDTH // RWKV_HEAD
DECAY_LORA = 64
AAA_LORA = 64
GATE_LORA = 128
GMLP_WIDTH = D_MODEL - RWKV_WIDTH
GMLP_HEADS = 8
GMLP_HEAD = GMLP_WIDTH // GMLP_HEADS
CHUNK = 128
D_FF = 2816
RMS_EPS = 1e-6
LN_EPS = 1e-5
GN_EPS = 64e-5
RWKV_COLS = 3 * RWKV_WIDTH + DECAY_LORA + AAA_LORA + GATE_LORA
IN_COLS = RWKV_COLS + 2 * GMLP_WIDTH
RWKV_SPLITS = (RWKV_WIDTH, 2 * RWKV_WIDTH, 3 * RWKV_WIDTH,
               3 * RWKV_WIDTH + DECAY_LORA, 3 * RWKV_WIDTH + DECAY_LORA + AAA_LORA)

kernel_name = 'hybrid_rwkv7_chunked_gmlp_macaron_ple'


def rms_norm(x, g):
    xf = x.astype(jnp.float32)
    y = xf * lax.rsqrt(jnp.mean(xf * xf, axis=-1, keepdims=True) + RMS_EPS)
    return (y * g.astype(jnp.float32)).astype(x.dtype)


def layer_norm(x, g, b, eps):
    xf = x.astype(jnp.float32)
    mu = jnp.mean(xf, axis=-1, keepdims=True)
    var = jnp.mean(jnp.square(xf - mu), axis=-1, keepdims=True)
    y = (xf - mu) * lax.rsqrt(var + eps)
    return (y * g.astype(jnp.float32) + b.astype(jnp.float32)).astype(x.dtype)


def swiglu(x, w1, w3, w2):
    return (jax.nn.silu(x @ w1) * (x @ w3)) @ w2


def token_shift(z, mu):
    z_prev = jnp.pad(z[:, :-1], ((0, 0), (1, 0), (0, 0)))
    return z + (z_prev - z) * mu


def rwkv7_recurrence(r, decay, k, v, kk, a):
    B, T, H, N = r.shape

    def step(S, inp):
        r_t, d_t, k_t, v_t, kk_t, a_t = inp
        sa = jnp.einsum('bhvk,bhk->bhv', S, -kk_t)
        S = (S * d_t[:, :, None, :]
             + sa[..., None] * (kk_t * a_t)[:, :, None, :]
             + v_t[..., None] * k_t[:, :, None, :])
        y_t = jnp.einsum('bhvk,bhk->bhv', S, r_t)
        return S, y_t

    xs = (jnp.moveaxis(r, 1, 0), jnp.moveaxis(decay, 1, 0), jnp.moveaxis(k, 1, 0),
          jnp.moveaxis(v, 1, 0), jnp.moveaxis(kk, 1, 0), jnp.moveaxis(a, 1, 0))
    S0 = jnp.zeros((B, H, N, N), jnp.float32)
    _, y = lax.scan(step, S0, xs)
    return jnp.moveaxis(y, 0, 1)


def rwkv7_group(z, mu, w0, w_decay, a0, w_aaa, w_gate, k_k, k_a, r_k, gn_g, gn_b):
    B, T, _ = z.shape
    H, N = RWKV_HEADS, RWKV_HEAD
    z = token_shift(z, mu)
    r, k, v, zw, za, zg = jnp.split(z, RWKV_SPLITS, axis=-1)
    logw = -jax.nn.softplus(-(w0 + jnp.tanh(zw) @ w_decay)) - 0.5
    decay = jnp.exp(-jnp.exp(logw.astype(jnp.float32)))
    a = jax.nn.sigmoid(a0 + za @ w_aaa)
    g = jax.nn.sigmoid(zg) @ w_gate
    kk = (k * k_k).reshape(B, T, H, N).astype(jnp.float32)
    kk = kk / jnp.maximum(jnp.linalg.norm(kk, axis=-1, keepdims=True), 1e-12)
    k = k * (1.0 + (a - 1.0) * k_a)
    hd = lambda t: t.reshape(B, T, H, N).astype(jnp.float32)
    r4, k4, v4, a4, d4 = hd(r), hd(k), hd(v), hd(a), hd(decay)
    y = rwkv7_recurrence(r4, d4, k4, v4, kk, a4)
    y = layer_norm(y, gn_g.reshape(H, N), gn_b.reshape(H, N), GN_EPS)
    y = y + jnp.sum(r4 * k4 * r_k.astype(jnp.float32), axis=-1, keepdims=True) * v4
    return (y.reshape(B, T, RWKV_WIDTH) * g).astype(z.dtype)


def chunked_sgu_group(z, ln_g, ln_b, w_s, b_s):
    B, T, _ = z.shape
    u, v = jnp.split(jax.nn.gelu(z, approximate=False), 2, axis=-1)
    v = layer_norm(v, ln_g, ln_b, LN_EPS)
    v = v.reshape(B, T // CHUNK, CHUNK, GMLP_HEADS, GMLP_HEAD)
    causal = jnp.tril(jnp.ones((CHUNK, CHUNK), dtype=bool))
    ws = jnp.where(causal[None], w_s, jnp.zeros_like(w_s))
    mixed = jnp.einsum('hts,bcshd->bcthd', ws, v) + b_s.T[None, None, :, :, None]
    return u * mixed.reshape(B, T, GMLP_WIDTH)


def setup_inputs(seed: int = 0) -> dict:
    key = jax.random.key(seed)
    ks = jax.random.split(key, 40)
    L, D = DEPTH, D_MODEL

    def nrm(k, shape, scale):
        return jax.random.normal(k, shape, jnp.float32) * scale

    def gain(k, shape):
        return 1.0 + nrm(k, shape, 0.05)

    return {
        'x': nrm(ks[0], (BATCH, SEQ, D), 1.0),
        'p': nrm(ks[1], (DEPTH, BATCH, SEQ, PLE_DIM), 1.0),
        'norm_ffn1': gain(ks[2], (L, D)),
        'ffn1_w1': nrm(ks[3], (L, D, D_FF), D ** -0.5),
        'ffn1_w3': nrm(ks[4], (L, D, D_FF), D ** -0.5),
        'ffn1_w2': nrm(ks[5], (L, D_FF, D), D_FF ** -0.5),
        'norm_mix': gain(ks[6], (L, D)),
        'w_in': nrm(ks[7], (L, D, IN_COLS), D ** -0.5),
        'shift_mu': jax.random.uniform(ks[8], (L, RWKV_COLS), jnp.float32),
        'rwkv_w0': jax.random.uniform(ks[9], (L, RWKV_WIDTH), jnp.float32, -6.5, -1.5),
        'rwkv_w_decay': nrm(ks[10], (L, DECAY_LORA, RWKV_WIDTH), 0.1 * DECAY_LORA ** -0.5),
        'rwkv_a0': nrm(ks[11], (L, RWKV_WIDTH), 0.1),
        'rwkv_w_aaa': nrm(ks[12], (L, AAA_LORA, RWKV_WIDTH), AAA_LORA ** -0.5),
        'rwkv_w_gate': nrm(ks[13], (L, GATE_LORA, RWKV_WIDTH), GATE_LORA ** -0.5),
        'rwkv_k_k': 0.85 + nrm(ks[14], (L, RWKV_WIDTH), 0.05),
        'rwkv_k_a': 1.0 + nrm(ks[15], (L, RWKV_WIDTH), 0.05),
        'rwkv_r_k': nrm(ks[16], (L, RWKV_HEADS, RWKV_HEAD), 0.1),
        'rwkv_gn_g': gain(ks[17], (L, RWKV_WIDTH)),
        'rwkv_gn_b': nrm(ks[18], (L, RWKV_WIDTH), 0.02),
        'sgu_ln_g': gain(ks[19], (L, GMLP_WIDTH)),
        'sgu_ln_b': nrm(ks[20], (L, GMLP_WIDTH), 0.02),
        'sgu_w_s': nrm(ks[21], (L, GMLP_HEADS, CHUNK, CHUNK), 0.5 * CHUNK ** -0.5),
        'sgu_b_s': 1.0 + nrm(ks[22], (L, GMLP_HEADS, CHUNK), 0.1),
        'w_out': nrm(ks[23], (L, D, D), D ** -0.5),
        'norm_ffn2': gain(ks[24], (L, D)),
        'ffn2_w1': nrm(ks[25], (L, D, D_FF), D ** -0.5),
        'ffn2_w3': nrm(ks[26], (L, D, D_FF), D ** -0.5),
        'ffn2_w2': nrm(ks[27], (L, D_FF, D), D_FF ** -0.5),
        'norm_ple': gain(ks[28], (L, D)),
        'w_ple_gate': nrm(ks[29], (L, D, D), D ** -0.5),
        'w_ple': nrm(ks[30], (L, PLE_DIM, D), PLE_DIM ** -0.5),
        'norm_final': gain(ks[31], (D,)),
    }


def reference(x, p, norm_ffn1, ffn1_w1, ffn1_w3, ffn1_w2, norm_mix, w_in, shift_mu,
              rwkv_w0, rwkv_w_decay, rwkv_a0, rwkv_w_aaa, rwkv_w_gate, rwkv_k_k, rwkv_k_a,
              rwkv_r_k, rwkv_gn_g, rwkv_gn_b, sgu_ln_g, sgu_ln_b, sgu_w_s, sgu_b_s, w_out,
              norm_ffn2, ffn2_w1, ffn2_w3, ffn2_w2, norm_ple, w_ple_gate, w_ple, norm_final):
    h = x
    for i in range(DEPTH):
        h = h + 0.5 * swiglu(rms_norm(h, norm_ffn1[i]), ffn1_w1[i], ffn1_w3[i], ffn1_w2[i])
        n = rms_norm(h, norm_mix[i])
        z = n @ w_in[i]
        y_rwkv = rwkv7_group(z[..., :RWKV_COLS], shift_mu[i], rwkv_w0[i], rwkv_w_decay[i],
                             rwkv_a0[i], rwkv_w_aaa[i], rwkv_w_gate[i], rwkv_k_k[i],
                             rwkv_k_a[i], rwkv_r_k[i], rwkv_gn_g[i], rwkv_gn_b[i])
        y_sgu = chunked_sgu_group(z[..., RWKV_COLS:], sgu_ln_g[i], sgu_ln_b[i],
                                  sgu_w_s[i], sgu_b_s[i])
        y = jnp.concatenate([y_rwkv, y_sgu], axis=-1)
        h = h + y @ w_out[i]
        h = h + 0.5 * swiglu(rms_norm(h, norm_ffn2[i]), ffn2_w1[i], ffn2_w3[i], ffn2_w2[i])
        gate = jax.nn.sigmoid(rms_norm(h, norm_ple[i]) @ w_ple_gate[i])
        h = h + gate * (p[i] @ w_ple[i])
    return rms_norm(h, norm_final)
```

```cpp
#include <hip/hip_runtime.h>
#include <hip/hip_cooperative_groups.h>
#include <cstdio>
#include <cstdint>
namespace cg = cooperative_groups;

namespace pg8 {
#define PG8_LAS __attribute__((address_space(3)))
typedef unsigned short bf16_t;
typedef short bf16x8 __attribute__((ext_vector_type(8)));
typedef float f32x4 __attribute__((ext_vector_type(4)));
typedef unsigned u32x4 __attribute__((ext_vector_type(4)));
constexpr int BM = 256, BK = 64, HALF = 128, HTB = HALF * BK * 2  , STAGE_BYTES = 8 * HTB, NXCD = 8, WGM = 8;

__host__ __device__ __forceinline__ int lds_byte(int r, int c) { const int st = (r >> 4) * 2 + (c >> 5), rr = r & 15, cc = c & 31, ob = rr * 64 + cc * 2; return st * 1024 + (ob ^ (((ob >> 9) & 1) << 5)); }
__host__ __device__ __forceinline__ void stage_rc(int b, int& R, int& C) { const int st = b / 1024, sb = b % 1024, swz = sb ^ (((sb >> 9) & 1) << 5); R = (st >> 1) * 16 + swz / 64; C = (st & 1) * 32 + (swz % 64) / 2; }
__host__ __device__ __forceinline__ int perm32(int rho) { const int n = rho >> 4, i = rho & 15; return 8 * (i >> 2) + 4 * n + (i & 3); }

struct Unit { int pm, pn; };
struct Gemm { const bf16_t* A; const bf16_t* Bt; int M, N, K; };

struct StaticOrder {
    int nM, nN, nwg, G, c;
    __host__ __device__ void init(int M, int N, int G_, int c_) { nM = M / BM; nN = N / BM; nwg = nM * nN; G = G_; c = c_; }
    __host__ __device__ bool next(int i, Unit& u) const {
        const long L = (long)i * G + c; if (L >= nwg) return false;
        int wgid = (int)L; { const int q = nwg / NXCD, r = nwg % NXCD, xcd = wgid % NXCD, off = wgid / NXCD; wgid = (xcd < r ? xcd * (q + 1) : r * (q + 1) + (xcd - r) * q) + off; }
        const int nig = WGM * nN, gid = wgid / nig, fm = gid * WGM, gsz = (nM - fm) < WGM ? (nM - fm) : WGM;
        u.pm = fm + ((wgid % nig) % gsz); u.pn = (wgid % nig) / gsz; return true;
    }
    __device__ __forceinline__ void a_ready(const Unit&) const {}
    __device__ __forceinline__ void done(const Unit&) const {}
};

__device__ __forceinline__ unsigned cvt_pk_bf16(float lo, float hi) { unsigned r; asm volatile("v_cvt_pk_bf16_f32 %0, %1, %2" : "=v"(r) : "v"(lo), "v"(hi)); return r; }
template <class Epi, class Sched, bool ALIGN_EPI = false, bool SP2 = false>
__device__ __forceinline__ void gemm_phase(PG8_LAS unsigned char* lds, const Gemm g, const Sched& S, const Epi& E) {
    const int tid = threadIdx.x, wid = __builtin_amdgcn_readfirstlane(tid >> 6), lane = tid & 63, wr = wid >> 2, wc = wid & 3, fr = lane & 15, fq = lane >> 4;
    const int K = g.K, nt = K / BK;
    unsigned voffA[2], voffB[2];
#pragma unroll
    for (int i = 0; i < 2; ++i) { int R, C; stage_rc(tid * 16 + i * 8192, R, C); const int Rb = Epi::PERM ? ((R & ~31) + perm32(R & 31)) : R;
        voffA[i] = (unsigned)(R * K + C) * 2u; voffB[i] = (unsigned)(Rb * K + C) * 2u; }
    const size_t kstep = (size_t)(BK * 2);
    const size_t hstep = (size_t)HALF * K * 2;
    const size_t tstep = 2 * hstep;
    const unsigned ldsw = (unsigned)wid * 1024u;
    const int aoff = lds_byte(wr * 64 + fr, fq * 8), boff = lds_byte(wc * 32 + fr, fq * 8);
#define PG8_SA(b, h) (((b) * 2 + (h)) * HTB)
#define PG8_SB(b, h) ((4 + (b) * 2 + (h)) * HTB)
#define PG8_STAGE(bufoff, gbase, voff) do { _Pragma("unroll") for (int _i = 0; _i < 2; ++_i) \
        __builtin_amdgcn_global_load_lds((const unsigned*)((const char*)(gbase) + (voff)[_i]), (PG8_LAS unsigned*)(lds + (bufoff) + ldsw + _i * 8192), 16, 0, 0); } while (0)
#define PG8_LDA(dst, b, h) do { _Pragma("unroll") for (int m = 0; m < 4; ++m) _Pragma("unroll") for (int k = 0; k < 2; ++k) dst[m][k] = *(const PG8_LAS bf16x8*)(lds + PG8_SA(b, h) + aoff + m * 2048 + k * 1024); } while (0)
#define PG8_LDB(dst, b, h) do { _Pragma("unroll") for (int n = 0; n < 2; ++n) _Pragma("unroll") for (int k = 0; k < 2; ++k) dst[n][k] = *(const PG8_LAS bf16x8*)(lds + PG8_SB(b, h) + boff + n * 2048 + k * 1024); } while (0)
#define PG8_MMA(ai, bj, At, Bt) do { __builtin_amdgcn_s_setprio(1); _Pragma("unroll") for (int m = 0; m < 4; ++m) _Pragma("unroll") for (int n = 0; n < 2; ++n) _Pragma("unroll") for (int k = 0; k < 2; ++k) \
        acc[ai][bj][m][n] = __builtin_amdgcn_mfma_f32_16x16x32_bf16(Bt[n][k], At[m][k], acc[ai][bj][m][n], 0, 0, 0); __builtin_amdgcn_s_setprio(0); } while (0)
#define PG8_WAIT_V(n) asm volatile("s_waitcnt vmcnt(" #n ")" ::: "memory")
#define PG8_WAIT_L(n) asm volatile("s_waitcnt lgkmcnt(" #n ")" ::: "memory")
#define PG8_BAR __builtin_amdgcn_s_barrier()
#define PG8_SCHED __builtin_amdgcn_sched_barrier(0)
    Unit cur, nxt; int ui = 0;
    if (!S.next(0, cur)) return;
    f32x4 acc[2][2][4][2];
#pragma unroll
    for (int a = 0; a < 2; ++a)
#pragma unroll
        for (int b = 0; b < 2; ++b)
#pragma unroll
            for (int m = 0; m < 4; ++m)
#pragma unroll
                for (int n = 0; n < 2; ++n) acc[a][b][m][n] = (f32x4){0.f, 0.f, 0.f, 0.f};
    bf16x8 At[4][2], B0[2][2], B1[2][2];
    const char* cA = (const char*)g.A + (size_t)cur.pm * tstep; const char* cB = (const char*)g.Bt + (size_t)cur.pn * tstep;
    S.a_ready(cur);
    if constexpr (SP2) {
        PG8_STAGE(PG8_SB(0, 0), cB, voffB); PG8_STAGE(PG8_SB(0, 1), cB + hstep, voffB); PG8_STAGE(PG8_SA(0, 0), cA, voffA); PG8_STAGE(PG8_SA(0, 1), cA + hstep, voffA);
        if (wr == 1) PG8_BAR;
        PG8_WAIT_V(2); PG8_BAR;
        PG8_STAGE(PG8_SB(1, 0), cB + kstep, voffB); PG8_STAGE(PG8_SA(1, 0), cA + kstep, voffA); PG8_STAGE(PG8_SB(1, 1), cB + hstep + kstep, voffB);
        PG8_WAIT_V(6); PG8_BAR;
    } else {
        PG8_STAGE(PG8_SB(0, 0), cB, voffB); PG8_STAGE(PG8_SA(0, 0), cA, voffA); PG8_STAGE(PG8_SB(0, 1), cB + hstep, voffB); PG8_STAGE(PG8_SA(0, 1), cA + hstep, voffA);
        if (wr == 1) PG8_BAR;
        PG8_WAIT_V(4); PG8_BAR;
        PG8_STAGE(PG8_SB(1, 0), cB + kstep, voffB); PG8_STAGE(PG8_SA(1, 0), cA + kstep, voffA); PG8_STAGE(PG8_SB(1, 1), cB + hstep + kstep, voffB);
        PG8_WAIT_V(6); PG8_BAR;
    }
    for (;;) {
        const bool has_next = S.next(ui + 1, nxt);
        const char* nA = has_next ? (const char*)g.A + (size_t)nxt.pm * tstep : cA; const char* nB = has_next ? (const char*)g.Bt + (size_t)nxt.pn * tstep : cB;
        for (int t = 0; t < nt; t += 2) {
            const bool last = (t == nt - 2);
            const char* a1 = cA + (size_t)(t + 1) * kstep;
            const char* a2 = last ? nA : cA + (size_t)(t + 2) * kstep; const char* b2 = last ? nB : cB + (size_t)(t + 2) * kstep;
            const char* a3 = a2 + kstep; const char* b3 = b2 + kstep;
            if (last && has_next) S.a_ready(nxt);
            if constexpr (SP2) {
            PG8_LDB(B0, 0, 0); PG8_LDB(B1, 0, 1); PG8_SCHED; PG8_LDA(At, 0, 0); PG8_STAGE(PG8_SA(1, 1), a1 + hstep, voffA);
            PG8_WAIT_V(8); PG8_WAIT_L(0); PG8_BAR; PG8_MMA(0, 0, At, B0); PG8_MMA(0, 1, At, B1); PG8_BAR; PG8_SCHED;
            PG8_LDA(At, 0, 1); PG8_STAGE(PG8_SB(0, 0), b2, voffB); PG8_STAGE(PG8_SB(0, 1), b2 + hstep, voffB); PG8_STAGE(PG8_SA(0, 0), a2, voffA);
            PG8_WAIT_V(8); PG8_WAIT_L(0); PG8_BAR; PG8_MMA(1, 0, At, B0); PG8_MMA(1, 1, At, B1); PG8_BAR; PG8_SCHED;
            PG8_LDB(B0, 1, 0); PG8_LDB(B1, 1, 1); PG8_SCHED; PG8_LDA(At, 1, 0); PG8_STAGE(PG8_SA(0, 1), a2 + hstep, voffA);
            PG8_WAIT_V(8); PG8_WAIT_L(0); PG8_BAR; PG8_MMA(0, 0, At, B0); PG8_MMA(0, 1, At, B1); PG8_BAR; PG8_SCHED;
            PG8_LDA(At, 1, 1); PG8_STAGE(PG8_SB(1, 0), b3, voffB); PG8_STAGE(PG8_SB(1, 1), b3 + hstep, voffB); PG8_STAGE(PG8_SA(1, 0), a3, voffA);
            PG8_WAIT_V(8); PG8_WAIT_L(0); PG8_BAR; PG8_MMA(1, 0, At, B0); PG8_MMA(1, 1, At, B1); PG8_BAR; PG8_SCHED;
            } else {
            PG8_LDB(B0, 0, 0); PG8_SCHED; PG8_LDA(At, 0, 0); PG8_STAGE(PG8_SA(1, 1), a1 + hstep, voffA);
            PG8_WAIT_L(8); PG8_BAR; PG8_WAIT_L(0); PG8_MMA(0, 0, At, B0); PG8_BAR; PG8_SCHED;
            PG8_LDB(B1, 0, 1); PG8_STAGE(PG8_SB(0, 0), b2, voffB);
            PG8_BAR; PG8_WAIT_L(0); PG8_MMA(0, 1, At, B1); PG8_BAR;
            PG8_LDA(At, 0, 1); PG8_STAGE(PG8_SA(0, 0), a2, voffA);
            PG8_BAR; PG8_WAIT_L(0); PG8_MMA(1, 0, At, B0); PG8_BAR; PG8_SCHED;
            PG8_STAGE(PG8_SB(0, 1), b2 + hstep, voffB);
            PG8_WAIT_V(6); PG8_BAR; PG8_MMA(1, 1, At, B1); PG8_BAR;
            PG8_LDB(B0, 1, 0); PG8_SCHED; PG8_LDA(At, 1, 0); PG8_STAGE(PG8_SA(0, 1), a2 + hstep, voffA);
            PG8_WAIT_L(8); PG8_BAR; PG8_WAIT_L(0); PG8_MMA(0, 0, At, B0); PG8_BAR; PG8_SCHED;
            PG8_LDB(B1, 1, 1); PG8_STAGE(PG8_SB(1, 0), b3, voffB);
            PG8_BAR; PG8_WAIT_L(0); PG8_MMA(0, 1, At, B1); PG8_BAR;
            PG8_LDA(At, 1, 1); PG8_STAGE(PG8_SA(1, 0), a3, voffA);
            PG8_BAR; PG8_WAIT_L(0); PG8_MMA(1, 0, At, B0); PG8_BAR; PG8_SCHED;
            PG8_STAGE(PG8_SB(1, 1), b3 + hstep, voffB);
            PG8_WAIT_V(6); PG8_BAR; PG8_MMA(1, 1, At, B1); PG8_BAR;
            }
        }
        if constexpr (ALIGN_EPI) { if (wr == 0) PG8_BAR; }
        if constexpr (!Epi::AFTER_DRAIN) { E(acc, cur, wr, wc, fr, fq); S.done(cur); }
        if (!has_next) break;
#pragma unroll
        for (int a = 0; a < 2; ++a)
#pragma unroll
            for (int b = 0; b < 2; ++b)
#pragma unroll
                for (int m = 0; m < 4; ++m)
#pragma unroll
                    for (int n = 0; n < 2; ++n) acc[a][b][m][n] = (f32x4){0.f, 0.f, 0.f, 0.f};
        cur = nxt; cA = nA; cB = nB; ++ui;
        if constexpr (ALIGN_EPI) { if (wr == 1) PG8_BAR; }
    }
    PG8_WAIT_V(0);
    if constexpr (!ALIGN_EPI) { if (wr == 0) PG8_BAR; }
    PG8_BAR;
    if constexpr (Epi::AFTER_DRAIN) { E.fused(acc, cur, wr, wc, fr, fq, lds, wid, lane); S.done(cur); }
#undef PG8_SA
#undef PG8_SB
#undef PG8_STAGE
#undef PG8_LDA
#undef PG8_LDB
#undef PG8_MMA
#undef PG8_WAIT_V
#undef PG8_WAIT_L
#undef PG8_BAR
#undef PG8_SCHED
}
}

using pg8::bf16_t; using pg8::bf16x8; using pg8::f32x4; using pg8::u32x4; using pg8::Unit;
#define LAS __attribute__((address_space(3)))
typedef unsigned u32x2 __attribute__((ext_vector_type(2)));
typedef float f32x2 __attribute__((ext_vector_type(2)));

constexpr int T_ = 16384, D_ = 1024, FF_ = 2816, RC_ = 1792, NTHR = 512, GWD_ = 512;
constexpr int LDS_BYTES = 163840;
constexpr int MS = 68;
constexpr int MBYTES = 64 * MS * 4;
constexpr int MISC_OFF = 9 * MBYTES;
constexpr int NCH = 256, NGRP = 32, GCH = 8;

constexpr size_t MiB = 1ull << 20;
constexpr size_t WS_HID = 0, WS_ZR = 0, WS_ZG = 56 * MiB, WS_PE = 0, WS_H4 = 32 * MiB;
constexpr size_t WS_ACTA = 88 * MiB, WS_ACTB = 120 * MiB;
constexpr size_t WS_W13A = 152 * MiB, WS_W2A = 163 * MiB, WS_WIN = 163 * MiB + 512 * 1024 * 11, WS_WOUT = 252 * MiB;
constexpr size_t WS_P = 120 * MiB, WS_Q = 152 * MiB, WS_Y0 = 184 * MiB, WS_RC = 200 * MiB, WS_G = 216 * MiB;
constexpr size_t WS_PC = 232 * MiB, WS_QC = 236 * MiB, WS_SG = 240 * MiB, WS_BON = 244 * MiB, WS_LNST = 245 * MiB;
constexpr size_t WS_SSQA = 246 * MiB, WS_SSQB = 247 * MiB;
constexpr size_t WS_W13B = 152 * MiB, WS_W2B = 163 * MiB, WS_WG = 163 * MiB + 512 * 1024 * 11, WS_WPLE = 171 * MiB, WS_PB = 172 * MiB;

typedef __bf16 bf16x2_t __attribute__((ext_vector_type(2)));
__device__ __forceinline__ unsigned pk2(float lo, float hi) { const f32x2 v = {lo, hi}; const bf16x2_t b = __builtin_convertvector(v, bf16x2_t); return __builtin_bit_cast(unsigned, b); }
__device__ __forceinline__ float bf2f(bf16_t b) { return __uint_as_float(((unsigned)b) << 16); }
__device__ __forceinline__ bf16_t f2bf(float f) { return (bf16_t)(pk2(f, 0.f) & 0xffffu); }
__device__ __forceinline__ float dpp_f(float v, const int ctrl_sel) {
    int i = __float_as_int(v), r;
    if (ctrl_sel == 0) r = __builtin_amdgcn_update_dpp(i, i, 0xB1, 0xF, 0xF, false);
    else if (ctrl_sel == 1) r = __builtin_amdgcn_update_dpp(i, i, 0x4E, 0xF, 0xF, false);
    else if (ctrl_sel == 2) r = __builtin_amdgcn_update_dpp(i, i, 0x141, 0xF, 0xF, false);
    else r = __builtin_amdgcn_update_dpp(i, i, 0x140, 0xF, 0xF, false);
    return __int_as_float(r);
}
__device__ __forceinline__ float wave_sum(float v) {
    v += dpp_f(v, 0); v += dpp_f(v, 1); v += dpp_f(v, 2); v += dpp_f(v, 3);
    const int vi = __float_as_int(v);
    const float s0 = __int_as_float(__builtin_amdgcn_readlane(vi, 0)), s1 = __int_as_float(__builtin_amdgcn_readlane(vi, 16)), s2 = __int_as_float(__builtin_amdgcn_readlane(vi, 32)), s3 = __int_as_float(__builtin_amdgcn_readlane(vi, 48));
    return (s0 + s1) + (s2 + s3);
}
__device__ __forceinline__ float row_rstd(const float* ssq, int row) {
    const f32x4* p = (const f32x4*)(ssq + (size_t)row * 16);
    const f32x4 a = p[0], b = p[1], c = p[2], d = p[3];
    const float s = (((a[0] + a[1]) + (a[2] + a[3])) + ((b[0] + b[1]) + (b[2] + b[3]))) + (((c[0] + c[1]) + (c[2] + c[3])) + ((d[0] + d[1]) + (d[2] + d[3])));
    return 1.0f / sqrtf(s * (1.0f / 1024.0f) + 1e-6f);
}
__device__ __forceinline__ float row_rstd_q(const float* ssq, int row, int fq) {
    const f32x4 a = ((const f32x4*)(ssq + (size_t)row * 16))[fq];
    float s = (a[0] + a[1]) + (a[2] + a[3]);
    s += __shfl_xor(s, 16); s += __shfl_xor(s, 32);
    return 1.0f / sqrtf(s * (1.0f / 1024.0f) + 1e-6f);
}
__device__ __forceinline__ float frcp(float x) { return __builtin_amdgcn_rcpf(x); }
__device__ __forceinline__ float gelu_erf(float v) {
    const float av = fabsf(v), t = frcp(av * 0.2316418882f + 1.0f);
    float qq = t * 0.5307027145f + (-0.7265760135f); qq = qq * t + 0.7107068705f; qq = qq * t + (-0.142248368f); qq = qq * t + 0.127414796f; qq = qq * t;
    const float e = __builtin_amdgcn_exp2f((v * v) * (-0.72134752044f));
    const float m = v * (qq * e);
    return v < 0.f ? m : v - m;
}
__device__ __forceinline__ float sigmoidf_(float x) { return frcp(1.0f + __expf(-x)); }
__device__ __forceinline__ float tanhf_(float x) { return 1.0f - 2.0f * frcp(1.0f + __expf(2.0f * x)); }

struct EpiSwiGLU {
    static constexpr bool PERM = true, AFTER_DRAIN = false;
    bf16_t* O; const float* ssq;
    __device__ __forceinline__ void operator()(const f32x4 (&acc)[2][2][4][2], const Unit& u, int wr, int wc, int fr, int fq) const {
        const int row0 = u.pm * 256 + wr * 64 + fr, col0 = u.pn * 128 + wc * 16 + fq * 4;
#pragma unroll
        for (int ai = 0; ai < 2; ++ai)
#pragma unroll
            for (int m = 0; m < 4; ++m) {
                const int row = row0 + ai * 128 + m * 16; const float rs = row_rstd_q(ssq, row, fq);
#pragma unroll
                for (int bj = 0; bj < 2; ++bj) {
                    const f32x4 a = acc[ai][bj][m][0] * rs, b = acc[ai][bj][m][1] * rs; float h[4];
#pragma unroll
                    for (int j = 0; j < 4; ++j) h[j] = a[j] * frcp(1.0f + __expf(-a[j])) * b[j];
                    u32x2 w; w.x = pk2(h[0], h[1]); w.y = pk2(h[2], h[3]);
                    *(u32x2*)(O + (size_t)row * FF_ + col0 + bj * 64) = w;
                }
            }
    }
};
__device__ __forceinline__ f32x4 bflo4(unsigned a, unsigned b) { return (f32x4){__uint_as_float(a << 16), __uint_as_float(a & 0xffff0000u), __uint_as_float(b << 16), __uint_as_float(b & 0xffff0000u)}; }
template <int MODE, bool RLO, bool WLO> struct EpiResid {
    static constexpr bool PERM = true, AFTER_DRAIN = false;
    const float* basef; const bf16_t* bhi; const bf16_t* lo; bf16_t* olo; bf16_t* ohi; float* ssq; float scale;
    __device__ __forceinline__ void operator()(const f32x4 (&acc)[2][2][4][2], const Unit& u, int wr, int wc, int fr, int fq) const {
        const int row0 = u.pm * 256 + wr * 64 + fr, col0 = u.pn * 256 + wc * 32 + 8 * fq;
#pragma unroll
        for (int ai = 0; ai < 2; ++ai)
#pragma unroll
            for (int m = 0; m < 4; ++m) {
                const int row = row0 + ai * 128 + m * 16; float ss = 0.f;
#pragma unroll
                for (int bj = 0; bj < 2; ++bj) {
                    const size_t off = (size_t)row * D_ + col0 + bj * 128;
                    f32x4 b0, b1;
                    if (MODE == 0) { b0 = *(const f32x4*)(basef + off); b1 = *(const f32x4*)(basef + off + 4); }
                    else { const u32x4 h = *(const u32x4*)(bhi + off); b0 = bflo4(h.x, h.y); b1 = bflo4(h.z, h.w);
                           if (RLO) { const u32x4 l = *(const u32x4*)(lo + off); b0 = b0 + bflo4(l.x, l.y); b1 = b1 + bflo4(l.z, l.w); } }
                    const f32x4 v0 = b0 + acc[ai][bj][m][0] * scale, v1 = b1 + acc[ai][bj][m][1] * scale;
                    u32x4 w; w.x = pk2(v0[0], v0[1]); w.y = pk2(v0[2], v0[3]); w.z = pk2(v1[0], v1[1]); w.w = pk2(v1[2], v1[3]);
                    const f32x4 r0 = v0 - bflo4(w.x, w.y), r1 = v1 - bflo4(w.z, w.w);
                    u32x4 wl; wl.x = pk2(r0[0], r0[1]); wl.y = pk2(r0[2], r0[3]); wl.z = pk2(r1[0], r1[1]); wl.w = pk2(r1[2], r1[3]);
                    *(u32x4*)(ohi + off) = w; if (WLO) *(u32x4*)(olo + off) = wl;
                    ss += ((v0[0] * v0[0] + v0[1] * v0[1]) + (v0[2] * v0[2] + v0[3] * v0[3])) + ((v1[0] * v1[0] + v1[1] * v1[1]) + (v1[2] * v1[2] + v1[3] * v1[3]));
                }
                ss += __shfl_xor(ss, 16); ss += __shfl_xor(ss, 32);
                if (fq == 0) ssq[(size_t)row * 16 + u.pn * 4 + wc] = ss;
            }
    }
};
struct EpiZ {
    static constexpr bool PERM = true, AFTER_DRAIN = false;
    bf16_t* zr; bf16_t* zg; const float* ssq; float* lnst;
    __device__ __forceinline__ void operator()(const f32x4 (&acc)[2][2][4][2], const Unit& u, int wr, int wc, int fr, int fq) const {
        const int row0 = u.pm * 256 + wr * 64 + fr; const bool isg = u.pn >= 7;
        const int col0 = (isg ? (u.pn - 7) * 256 : u.pn * 256) + wc * 32 + 8 * fq;
        bf16_t* basep = isg ? zg : zr; const int ld = isg ? 1024 : RC_;
#pragma unroll
        for (int ai = 0; ai < 2; ++ai)
#pragma unroll
            for (int m = 0; m < 4; ++m) {
                const int row = row0 + ai * 128 + m * 16; const float rs = row_rstd_q(ssq, row, fq); float s1 = 0.f, s2 = 0.f;
#pragma unroll
                for (int bj = 0; bj < 2; ++bj) {
                    f32x4 v0 = acc[ai][bj][m][0] * rs, v1 = acc[ai][bj][m][1] * rs;
                    if (isg) {
#pragma unroll
                        for (int j = 0; j < 4; ++j) { v0[j] = gelu_erf(v0[j]); v1[j] = gelu_erf(v1[j]); }
                        s1 += ((v0[0] + v0[1]) + (v0[2] + v0[3])) + ((v1[0] + v1[1]) + (v1[2] + v1[3]));
                        s2 += ((v0[0] * v0[0] + v0[1] * v0[1]) + (v0[2] * v0[2] + v0[3] * v0[3])) + ((v1[0] * v1[0] + v1[1] * v1[1]) + (v1[2] * v1[2] + v1[3] * v1[3]));
                    }
                    u32x4 w; w.x = pk2(v0[0], v0[1]); w.y = pk2(v0[2], v0[3]); w.z = pk2(v1[0], v1[1]); w.w = pk2(v1[2], v1[3]);
                    *(u32x4*)(basep + (size_t)row * ld + col0 + bj * 128) = w;
                }
                if (u.pn >= 9) {
                    s1 += __shfl_xor(s1, 16); s1 += __shfl_xor(s1, 32); s2 += __shfl_xor(s2, 16); s2 += __shfl_xor(s2, 32);
                    if (fq == 0) { f32x2 o; o.x = s1; o.y = s2; *(f32x2*)(lnst + (size_t)row * 16 + ((u.pn - 9) * 4 + wc) * 2) = o; }
                }
            }
    }
};
struct EpiPE {
    static constexpr bool PERM = true, AFTER_DRAIN = false;
    bf16_t* pe;
    __device__ __forceinline__ void operator()(const f32x4 (&acc)[2][2][4][2], const Unit& u, int wr, int wc, int fr, int fq) const {
        const int row0 = u.pm * 256 + wr * 64 + fr, col0 = u.pn * 256 + wc * 32 + 8 * fq;
#pragma unroll
        for (int ai = 0; ai < 2; ++ai)
#pragma unroll
            for (int m = 0; m < 4; ++m)
#pragma unroll
                for (int bj = 0; bj < 2; ++bj) {
                    const size_t off = (size_t)(row0 + ai * 128 + m * 16) * D_ + col0 + bj * 128;
                    const f32x4 v0 = acc[ai][bj][m][0], v1 = acc[ai][bj][m][1];
                    u32x4 w; w.x = pk2(v0[0], v0[1]); w.y = pk2(v0[2], v0[3]); w.z = pk2(v1[0], v1[1]); w.w = pk2(v1[2], v1[3]);
                    *(u32x4*)(pe + off) = w;
                }
    }
};
struct EpiGate {
    static constexpr bool PERM = true, AFTER_DRAIN = false;
    const bf16_t* pe; const bf16_t* h3hi; const bf16_t* h3lo; bf16_t* h4; const float* ssq_in; float* ssq;
    __device__ __forceinline__ void operator()(const f32x4 (&acc)[2][2][4][2], const Unit& u, int wr, int wc, int fr, int fq) const {
        const int row0 = u.pm * 256 + wr * 64 + fr, col0 = u.pn * 256 + wc * 32 + 8 * fq;
#pragma unroll
        for (int ai = 0; ai < 2; ++ai)
#pragma unroll
            for (int m = 0; m < 4; ++m) {
                const int row = row0 + ai * 128 + m * 16; const float rs = row_rstd_q(ssq_in, row, fq); float ss = 0.f;
#pragma unroll
                for (int bj = 0; bj < 2; ++bj) {
                    const size_t off = (size_t)row * D_ + col0 + bj * 128;
                    const u32x4 hh = *(const u32x4*)(h3hi + off);
                    f32x4 b0 = bflo4(hh.x, hh.y), b1 = bflo4(hh.z, hh.w);
                    if (h3lo) { const u32x4 hl = *(const u32x4*)(h3lo + off); b0 = b0 + bflo4(hl.x, hl.y); b1 = b1 + bflo4(hl.z, hl.w); }
                    const u32x4 pw = *(const u32x4*)(pe + off);
                    const f32x4 p0 = (f32x4){__uint_as_float(pw.x << 16), __uint_as_float(pw.x & 0xffff0000u), __uint_as_float(pw.y << 16), __uint_as_float(pw.y & 0xffff0000u)};
                    const f32x4 p1 = (f32x4){__uint_as_float(pw.z << 16), __uint_as_float(pw.z & 0xffff0000u), __uint_as_float(pw.w << 16), __uint_as_float(pw.w & 0xffff0000u)};
                    f32x4 v0, v1;
#pragma unroll
                    for (int j = 0; j < 4; ++j) { v0[j] = b0[j] + sigmoidf_(acc[ai][bj][m][0][j] * rs) * p0[j]; v1[j] = b1[j] + sigmoidf_(acc[ai][bj][m][1][j] * rs) * p1[j]; }
                    u32x4 w; w.x = pk2(v0[0], v0[1]); w.y = pk2(v0[2], v0[3]); w.z = pk2(v1[0], v1[1]); w.w = pk2(v1[2], v1[3]);
                    *(u32x4*)(h4 + off) = w;
                    ss += ((v0[0] * v0[0] + v0[1] * v0[1]) + (v0[2] * v0[2] + v0[3] * v0[3])) + ((v1[0] * v1[0] + v1[1] * v1[1]) + (v1[2] * v1[2] + v1[3] * v1[3]));
                }
                ss += __shfl_xor(ss, 16); ss += __shfl_xor(ss, 32);
                if (fq == 0) ssq[(size_t)row * 16 + u.pn * 4 + wc] = ss;
            }
    }
};

struct EpiGateFinal {
    static constexpr bool PERM = true, AFTER_DRAIN = true;
    const bf16_t* pe; const bf16_t* h3hi; const bf16_t* h3lo  ; float* out; const float* gfin; const float* ssq_in; float* ssq; unsigned* cnt;
    __device__ __forceinline__ void operator()(const f32x4 (&)[2][2][4][2], const Unit&, int, int, int, int) const {}
    __device__ __forceinline__ void fused(const f32x4 (&acc_)[2][2][4][2], const Unit& u, int wr, int wc, int fr, int fq, LAS unsigned char*, int, int) const {
        f32x4 (&acc)[2][2][4][2] = const_cast<f32x4 (&)[2][2][4][2]>(acc_);
        const int row0 = u.pm * 256 + wr * 64 + fr, col0 = u.pn * 256 + wc * 32 + 8 * fq;
#pragma unroll
        for (int ai = 0; ai < 2; ++ai)
#pragma unroll
            for (int m = 0; m < 4; ++m) {
                const int row = row0 + ai * 128 + m * 16; const float rs = row_rstd_q(ssq_in, row, fq); float ss = 0.f;
#pragma unroll
                for (int bj = 0; bj < 2; ++bj) {
                    const size_t off = (size_t)row * D_ + col0 + bj * 128;
                    const u32x4 hh = *(const u32x4*)(h3hi + off);
                    f32x4 b0 = bflo4(hh.x, hh.y), b1 = bflo4(hh.z, hh.w);
                    if (h3lo) { const u32x4 hl = *(const u32x4*)(h3lo + off); b0 = b0 + bflo4(hl.x, hl.y); b1 = b1 + bflo4(hl.z, hl.w); }
                    const u32x4 pw = *(const u32x4*)(pe + off);
                    const f32x4 p0 = bflo4(pw.x, pw.y), p1 = bflo4(pw.z, pw.w);
                    f32x4 v0, v1;
#pragma unroll
                    for (int j = 0; j < 4; ++j) { v0[j] = b0[j] + sigmoidf_(acc[ai][bj][m][0][j] * rs) * p0[j]; v1[j] = b1[j] + sigmoidf_(acc[ai][bj][m][1][j] * rs) * p1[j]; }
                    acc[ai][bj][m][0] = v0; acc[ai][bj][m][1] = v1;
                    ss += ((v0[0] * v0[0] + v0[1] * v0[1]) + (v0[2] * v0[2] + v0[3] * v0[3])) + ((v1[0] * v1[0] + v1[1] * v1[1]) + (v1[2] * v1[2] + v1[3] * v1[3]));
                }
                ss += __shfl_xor(ss, 16); ss += __shfl_xor(ss, 32);
                if (fq == 0) ssq[(size_t)row * 16 + u.pn * 4 + wc] = ss;
            }
        asm volatile("s_waitcnt vmcnt(0)" ::: "memory");
        __syncthreads();
        if (threadIdx.x == 0) {
            __builtin_amdgcn_fence(__ATOMIC_RELEASE, "agent");
            asm volatile("s_waitcnt vmcnt(0)" ::: "memory");
            unsigned* c = cnt + 64 * u.pm;
            (void)__hip_atomic_fetch_add(c, 1u, __ATOMIC_RELAXED, __HIP_MEMORY_SCOPE_AGENT);
            unsigned sp = 0;
            while (__hip_atomic_load(c, __ATOMIC_RELAXED, __HIP_MEMORY_SCOPE_AGENT) < 4u) { __builtin_amdgcn_s_sleep(1); if (++sp > (1u << 22)) break; }
            __builtin_amdgcn_fence(__ATOMIC_ACQUIRE, "agent");
            asm volatile("s_waitcnt vmcnt(0)" ::: "memory");
        }
        __syncthreads();
        f32x4 g0[2], g1[2];
#pragma unroll
        for (int bj = 0; bj < 2; ++bj) { g0[bj] = *(const f32x4*)(gfin + col0 + bj * 128); g1[bj] = *(const f32x4*)(gfin + col0 + bj * 128 + 4); }
#pragma unroll
        for (int ai = 0; ai < 2; ++ai)
#pragma unroll
            for (int m = 0; m < 4; ++m) {
                const int row = row0 + ai * 128 + m * 16; const float rs = row_rstd_q(ssq, row, fq);
#pragma unroll
                for (int bj = 0; bj < 2; ++bj) {
                    const size_t off = (size_t)row * D_ + col0 + bj * 128;
                    *(f32x4*)(out + off) = acc[ai][bj][m][0] * rs * g0[bj]; *(f32x4*)(out + off + 4) = acc[ai][bj][m][1] * rs * g1[bj];
                }
            }
    }
};

__device__ __forceinline__ int map13(int hidden, int which) {
    const int pn = hidden >> 7, hl = hidden & 127;
    return pn * 256 + ((hl >> 6) << 7) + (((hl >> 4) & 3) << 5) + (((hl >> 2) & 3) << 3) + (which << 2) + (hl & 3);
}
__device__ __forceinline__ void transpose_item(const float* W, int K, int N, const float* gain, bf16_t* WT, int mode, LAS float* scr, int item, int lane) {
    const int nblk = N / 32, kb = item / nblk, nb = item % nblk, k0 = 64 * kb, n0 = 32 * nb;
#pragma unroll
    for (int i = 0; i < 32; ++i) { const int kk = 2 * i + (lane >> 5); float w = W[(size_t)(k0 + kk) * N + n0 + (lane & 31)]; if (gain) w *= gain[k0 + kk]; scr[kk * 33 + (lane & 31)] = w; }
    asm volatile("s_waitcnt lgkmcnt(0)" ::: "memory");
    const int c = lane & 7;
#pragma unroll
    for (int j = 0; j < 4; ++j) { const int n = (lane >> 3) + 8 * j; const LAS float* s = scr + (8 * c) * 33 + n;
        u32x4 o; o.x = pk2(s[0 * 33], s[1 * 33]); o.y = pk2(s[2 * 33], s[3 * 33]); o.z = pk2(s[4 * 33], s[5 * 33]); o.w = pk2(s[6 * 33], s[7 * 33]);
        const int row = (mode == 0) ? (n0 + n) : map13(n0 + n, mode - 1);
        *(u32x4*)(WT + (size_t)row * K + k0 + 8 * c) = o; }
    asm volatile("s_waitcnt lgkmcnt(0)" ::: "memory");
}

template <class FA, class FB>
__device__ __forceinline__ void mm_acc(f32x4 (&acc)[2], int K, int mrow, int nc0, int q, FA fa, FB fb) {
#pragma unroll 4
    for (int k0 = 0; k0 < K; k0 += 4) {
        const float a = fa(mrow, k0 + q), b0 = fb(k0 + q, nc0), b1 = fb(k0 + q, nc0 + 16);
        acc[0] = __builtin_amdgcn_mfma_f32_16x16x4f32(a, b0, acc[0], 0, 0, 0);
        acc[1] = __builtin_amdgcn_mfma_f32_16x16x4f32(a, b1, acc[1], 0, 0, 0);
    }
}
#define ZACC(a) do { a[0] = (f32x4){0.f, 0.f, 0.f, 0.f}; a[1] = (f32x4){0.f, 0.f, 0.f, 0.f}; } while (0)

struct Ctx {
    LAS unsigned char* lds; int tid, lane, wave, G, bid;
    const float* const* in; float* out; unsigned char* ws;
};
#define MAT(i) ((LAS float*)(C.lds + (i) * MBYTES))

__device__ __forceinline__ float zshift(const bf16_t* zr, int tok, int col, float mu) {
    const float cur = bf2f(zr[(size_t)tok * RC_ + col]);
    const float prv = bf2f(zr[(size_t)(tok > 0 ? tok - 1 : 0) * RC_ + col]) * (tok > 0 ? 1.f : 0.f);
    return cur + (prv - cur) * mu;
}

constexpr int BS = 72;
constexpr int BBYTES = 64 * BS * 2;
constexpr int F_OFF = 0, B_OFF = 3 * MBYTES;
constexpr int AMISC_OFF = B_OFF + 11 * BBYTES;
constexpr size_t WS_LORA = 254 * MiB;
#define FM(i) ((LAS float*)(C.lds + F_OFF + (i) * MBYTES))
#define BM_(i) ((LAS bf16_t*)(C.lds + B_OFF + (i) * BBYTES))
__device__ __forceinline__ void mmb(f32x4 (&acc)[2], const LAS bf16_t* A, const LAS bf16_t* B, int mrow, int nc0, int q) {
#pragma unroll
    for (int ks = 0; ks < 2; ++ks) {
        const bf16x8 a = *(const LAS bf16x8*)(A + mrow * BS + ks * 32 + q * 8);
        const bf16x8 b0 = *(const LAS bf16x8*)(B + nc0 * BS + ks * 32 + q * 8), b1 = *(const LAS bf16x8*)(B + (nc0 + 16) * BS + ks * 32 + q * 8);
        acc[0] = __builtin_amdgcn_mfma_f32_16x16x32_bf16(a, b0, acc[0], 0, 0, 0);
        acc[1] = __builtin_amdgcn_mfma_f32_16x16x32_bf16(a, b1, acc[1], 0, 0, 0);
    }
}
__device__ __forceinline__ void mmb_g(f32x4 (&acc)[2], const LAS bf16_t* A, const bf16_t* Bg, int ldb, int mrow, int nrow0, int q) {
#pragma unroll
    for (int ks = 0; ks < 2; ++ks) {
        const bf16x8 a = *(const LAS bf16x8*)(A + mrow * BS + ks * 32 + q * 8);
        const bf16x8 b0 = *(const bf16x8*)(Bg + (size_t)nrow0 * ldb + ks * 32 + q * 8), b1 = *(const bf16x8*)(Bg + (size_t)(nrow0 + 16) * ldb + ks * 32 + q * 8);
        acc[0] = __builtin_amdgcn_mfma_f32_16x16x32_bf16(a, b0, acc[0], 0, 0, 0);
        acc[1] = __builtin_amdgcn_mfma_f32_16x16x32_bf16(a, b1, acc[1], 0, 0, 0);
    }
}
__device__ __forceinline__ void mmb_gg(f32x4 (&acc)[2], const bf16_t* Ag, int lda, const bf16_t* Bg, int ldb, int mrow, int nrow0, int q) {
#pragma unroll
    for (int ks = 0; ks < 2; ++ks) {
        const bf16x8 a = *(const bf16x8*)(Ag + (size_t)mrow * lda + ks * 32 + q * 8);
        const bf16x8 b0 = *(const bf16x8*)(Bg + (size_t)nrow0 * ldb + ks * 32 + q * 8), b1 = *(const bf16x8*)(Bg + (size_t)(nrow0 + 16) * ldb + ks * 32 + q * 8);
        acc[0] = __builtin_amdgcn_mfma_f32_16x16x32_bf16(a, b0, acc[0], 0, 0, 0);
        acc[1] = __builtin_amdgcn_mfma_f32_16x16x32_bf16(a, b1, acc[1], 0, 0, 0);
    }
}
__device__ __forceinline__ void zload9(const bf16_t* zr, int tok, int col, bf16_t (&raw)[9]) {
    raw[0] = zr[(size_t)(tok > 0 ? tok - 1 : 0) * RC_ + col];
#pragma unroll
    for (int u = 0; u < 8; ++u) raw[u + 1] = zr[(size_t)(tok + u) * RC_ + col];
}
__device__ __forceinline__ void zmix8(const bf16_t (&raw)[9], float pz, float mu, float (&o)[8]) {
    float prv = bf2f(raw[0]) * pz;
#pragma unroll
    for (int u = 0; u < 8; ++u) { const float cur = bf2f(raw[u + 1]); o[u] = cur + (prv - cur) * mu; prv = cur; }
}
__device__ __forceinline__ u32x4 pack8(const float (&v)[8]) { u32x4 w; w.x = pk2(v[0], v[1]); w.y = pk2(v[2], v[3]); w.z = pk2(v[4], v[5]); w.w = pk2(v[6], v[7]); return w; }

__device__ __forceinline__ void rwkv_phase_a(const Ctx& C) {
    const bf16_t* zr = (const bf16_t*)(C.ws + WS_ZR);
    const float* mu = C.in[8]; const float* w0 = C.in[9]; const float* a0 = C.in[11];
    const float* k_k = C.in[14]; const float* k_a = C.in[15]; const float* r_k = C.in[16];
    const bf16_t* wdecT = (const bf16_t*)(C.ws + WS_LORA); const bf16_t* waaaT = wdecT + 512 * 64; const bf16_t* wgateT = waaaT + 512 * 64;
    float* Pg = (float*)(C.ws + WS_P); float* Qg = (float*)(C.ws + WS_Q); bf16_t* Y0g = (bf16_t*)(C.ws + WS_Y0); bf16_t* Rcg = (bf16_t*)(C.ws + WS_RC);
    bf16_t* Gg = (bf16_t*)(C.ws + WS_G); float* bon = (float*)(C.ws + WS_BON);
    LAS float* misc = (LAS float*)(C.lds + AMISC_OFF);
    LAS float* DI = (LAS float*)BM_(10);
    const int w = C.wave;
    const int mt = w >> 1, nt0 = (w & 1) * 2;

    bf16_t* scrg = (bf16_t*)(C.ws + WS_PC) + (size_t)C.bid * (64 * 256);
    for (int c = C.bid; c < NCH; c += C.G) {
      const int tok0 = c * 64;
      {
          int tid = C.tid; asm volatile("" : "+v"(tid));
          const int ci = tid & 63, tg8 = tid >> 6, tokb = tok0 + tg8 * 8;
          bf16_t r0[9], r1[9], r2[9], r3[9];
          zload9(zr, tokb, 1536 + ci, r0); zload9(zr, tokb, 1600 + ci, r1); zload9(zr, tokb, 1664 + ci, r2); zload9(zr, tokb, 1728 + ci, r3);
          const float m0 = mu[1536 + ci], m1 = mu[1600 + ci], m2 = mu[1664 + ci], m3 = mu[1728 + ci];
          const float pz = tokb > 0 ? 1.f : 0.f;
          float t8[8];
          zmix8(r0, pz, m0, t8);
#pragma unroll
          for (int u = 0; u < 8; ++u) scrg[(tg8 * 8 + u) * 256 + ci] = f2bf(tanhf_(t8[u]));
          zmix8(r1, pz, m1, t8);
#pragma unroll
          for (int u = 0; u < 8; ++u) scrg[(tg8 * 8 + u) * 256 + 64 + ci] = f2bf(t8[u]);
          zmix8(r2, pz, m2, t8);
#pragma unroll
          for (int u = 0; u < 8; ++u) scrg[(tg8 * 8 + u) * 256 + 128 + ci] = f2bf(sigmoidf_(t8[u]));
          zmix8(r3, pz, m3, t8);
#pragma unroll
          for (int u = 0; u < 8; ++u) scrg[(tg8 * 8 + u) * 256 + 192 + ci] = f2bf(sigmoidf_(t8[u]));
          asm volatile("s_waitcnt vmcnt(0)" ::: "memory");
          __syncthreads();
          __builtin_amdgcn_fence(__ATOMIC_ACQUIRE, "agent");
          asm volatile("s_waitcnt vmcnt(0)" ::: "memory");
      }
      bf16x8 Af[4][2], Bf[4][2][2]; bf16_t zn[3][9];
      {
          int tid = C.tid; asm volatile("" : "+v"(tid));
          const int lane = tid & 63, q = lane >> 4, l15 = lane & 15, mrow = mt * 16 + l15, nc0 = nt0 * 16 + l15, ci = tid & 63, tokb = tok0 + (tid >> 6) * 8;
#pragma unroll
          for (int g = 0; g < 4; ++g)
#pragma unroll
              for (int ks = 0; ks < 2; ++ks) Af[g][ks] = *(const bf16x8*)(scrg + (size_t)mrow * 256 + g * 64 + ks * 32 + q * 8);
#pragma unroll
          for (int ks = 0; ks < 2; ++ks)
#pragma unroll
              for (int i = 0; i < 2; ++i) { const int row = nc0 + 16 * i;
                  Bf[0][ks][i] = *(const bf16x8*)(wdecT + (size_t)row * 64 + ks * 32 + q * 8); Bf[1][ks][i] = *(const bf16x8*)(waaaT + (size_t)row * 64 + ks * 32 + q * 8);
                  Bf[2][ks][i] = *(const bf16x8*)(wgateT + (size_t)row * 128 + ks * 32 + q * 8); Bf[3][ks][i] = *(const bf16x8*)(wgateT + (size_t)row * 128 + 64 + ks * 32 + q * 8); }
          zload9(zr, tokb, ci, zn[0]); zload9(zr, tokb, 512 + ci, zn[1]); zload9(zr, tokb, 1024 + ci, zn[2]);
      }
      for (int h = 0; h < 8; ++h) {
        const int item = c * 8 + h;
        int tid = C.tid; asm volatile("" : "+v"(tid));
        const int lane = tid & 63, q = lane >> 4, l15 = lane & 15;
        const int mrow = mt * 16 + l15, nc0 = nt0 * 16 + l15;
        const int ci = tid & 63, tg8 = tid >> 6;
        const int tokb = tok0 + tg8 * 8;
        float rr[8], kx[8], vx[8];
        {
            const float m4 = mu[h * 64 + ci], m5 = mu[512 + h * 64 + ci], m6 = mu[1024 + h * 64 + ci];
            const float pz = tokb > 0 ? 1.f : 0.f;
            zmix8(zn[0], pz, m4, rr); zmix8(zn[1], pz, m5, kx); zmix8(zn[2], pz, m6, vx);
        }
        {
            f32x4 aw[2], aa[2], ag[2]; ZACC(aw); ZACC(aa); ZACC(ag);
#pragma unroll
            for (int ks = 0; ks < 2; ++ks)
#pragma unroll
                for (int i = 0; i < 2; ++i) {
                    aw[i] = __builtin_amdgcn_mfma_f32_16x16x32_bf16(Af[0][ks], Bf[0][ks][i], aw[i], 0, 0, 0);
                    aa[i] = __builtin_amdgcn_mfma_f32_16x16x32_bf16(Af[1][ks], Bf[1][ks][i], aa[i], 0, 0, 0);
                    ag[i] = __builtin_amdgcn_mfma_f32_16x16x32_bf16(Af[2][ks], Bf[2][ks][i], ag[i], 0, 0, 0);
                    ag[i] = __builtin_amdgcn_mfma_f32_16x16x32_bf16(Af[3][ks], Bf[3][ks][i], ag[i], 0, 0, 0);
                }
            if (h + 1 < 8) {
                const int hn = h + 1;
#pragma unroll
                for (int ks = 0; ks < 2; ++ks)
#pragma unroll
                    for (int i = 0; i < 2; ++i) { const int row = hn * 64 + nc0 + 16 * i;
                        Bf[0][ks][i] = *(const bf16x8*)(wdecT + (size_t)row * 64 + ks * 32 + q * 8); Bf[1][ks][i] = *(const bf16x8*)(waaaT + (size_t)row * 64 + ks * 32 + q * 8);
                        Bf[2][ks][i] = *(const bf16x8*)(wgateT + (size_t)row * 128 + ks * 32 + q * 8); Bf[3][ks][i] = *(const bf16x8*)(wgateT + (size_t)row * 128 + 64 + ks * 32 + q * 8); }
                zload9(zr, tokb, hn * 64 + ci, zn[0]); zload9(zr, tokb, 512 + hn * 64 + ci, zn[1]); zload9(zr, tokb, 1024 + hn * 64 + ci, zn[2]);
            }
#pragma unroll
            for (int i = 0; i < 2; ++i) {
                const int ch = nc0 + 16 * i; const float w0c = w0[h * 64 + ch], a0c = a0[h * 64 + ch];
#pragma unroll
                for (int j = 0; j < 4; ++j) {
                    const int t = mt * 16 + 4 * q + j;
                    FM(0)[t * MS + ch] = -0.60653065971f * sigmoidf_(w0c + aw[i][j]);
                    FM(1)[t * MS + ch] = sigmoidf_(a0c + aa[i][j]);
                    Gg[(size_t)(tok0 + t) * GWD_ + h * 64 + ch] = f2bf(ag[i][j]);
                }
            }
        }
        __syncthreads();
        {
            float ld[8], av[8], kkv[8], k2[8], cl[8];
            const float kkc = k_k[h * 64 + ci], kac = k_a[h * 64 + ci], rkc = r_k[h * 64 + ci];
            float run = 0.f;
#pragma unroll
            for (int u = 0; u < 8; ++u) {
                const int t = tg8 * 8 + u;
                ld[u] = FM(0)[t * MS + ci]; av[u] = FM(1)[t * MS + ci];
                const float kr = kx[u] * kkc; const float n2 = wave_sum(kr * kr);
                kkv[u] = kr * __builtin_amdgcn_rsqf(fmaxf(n2, 1e-24f));
                k2[u] = kx[u] * (1.0f + (av[u] - 1.0f) * kac);
                const float bs = wave_sum(rr[u] * k2[u] * rkc);
                if (lane == 0) bon[(size_t)(tok0 + t) * 8 + h] = bs;
                run += ld[u]; cl[u] = run;
            }
            misc[64 + tg8 * 64 + ci] = run;
            __syncthreads();
            float pre = 0.f, tot = 0.f;
#pragma unroll
            for (int g = 0; g < 8; ++g) { const float v = misc[64 + g * 64 + ci]; tot += v; if (g < tg8) pre += v; }
            if (tg8 == 0) misc[ci] = __expf(tot);
            float bh[8], kh[8];
#pragma unroll
            for (int u = 0; u < 8; ++u) {
                const int t = tg8 * 8 + u; const float cu = cl[u] + pre, cp = cu - ld[u];
                const float e_m = __expf(-cu), e_p = __expf(cu), e_t = __expf(tot - cu);
                const float at = kkv[u] * __expf(cp);
                BM_(0)[t * BS + ci] = f2bf(at); FM(2)[t * MS + ci] = at;
                BM_(1)[t * BS + ci] = f2bf(kkv[u] * av[u] * e_m);
                BM_(2)[t * BS + ci] = f2bf(k2[u] * e_m);
                BM_(3)[t * BS + ci] = f2bf(rr[u] * e_p);
                bh[u] = kkv[u] * av[u] * e_t; kh[u] = k2[u] * e_t;
            }
            *(LAS u32x4*)(BM_(4) + ci * BS + tg8 * 8) = pack8(vx);
            *(LAS u32x4*)(BM_(5) + ci * BS + tg8 * 8) = pack8(bh);
            *(LAS u32x4*)(BM_(6) + ci * BS + tg8 * 8) = pack8(kh);
        }
        __syncthreads();
        {
            f32x4 x1[2], x2[2], x3[2], x4[2]; ZACC(x1); ZACC(x2); ZACC(x3); ZACC(x4);
            mmb(x1, BM_(0), BM_(2), mrow, nc0, q);
            mmb(x2, BM_(0), BM_(1), mrow, nc0, q);
            mmb(x3, BM_(3), BM_(1), mrow, nc0, q);
            mmb(x4, BM_(3), BM_(2), mrow, nc0, q);
#pragma unroll
            for (int i = 0; i < 2; ++i)
#pragma unroll
                for (int j = 0; j < 4; ++j) { const int r = mt * 16 + 4 * q + j, cc = nc0 + 16 * i;
                    BM_(7)[r * BS + cc] = f2bf(r > cc ? x1[i][j] : 0.f); FM(0)[r * MS + cc] = r > cc ? x2[i][j] : 0.f;
                    BM_(8)[r * BS + cc] = f2bf(r >= cc ? x3[i][j] : 0.f); BM_(9)[r * BS + cc] = f2bf(r >= cc ? x4[i][j] : 0.f); }
        }
        __syncthreads();
        {
            f32x4 x1[2]; ZACC(x1);
            mmb(x1, BM_(7), BM_(4), mrow, nc0, q);
#pragma unroll
            for (int i = 0; i < 2; ++i)
#pragma unroll
                for (int j = 0; j < 4; ++j) { const int r = mt * 16 + 4 * q + j, cc = nc0 + 16 * i; FM(1)[r * MS + cc] = x1[i][j]; }
            if (tid < 64) {
                const int blk = tid >> 4, col = tid & 15; const LAS float* L = FM(0) + (blk * 16) * MS + blk * 16;
                float x[16];
#pragma unroll
                for (int r = 0; r < 16; ++r) {
                    float a = (r == col) ? 1.f : 0.f;
#pragma unroll
                    for (int s2 = 0; s2 < r; ++s2) a -= L[r * MS + s2] * x[s2];
                    x[r] = a;
                }
#pragma unroll
                for (int r = 0; r < 16; ++r) DI[(blk * 16 + r) * 20 + col] = x[r];
            }
        }
        __syncthreads();
        {
            LAS float* RH = (w < 4) ? FM(2) : FM(1); const int cb = (w & 3) * 16;
            const LAS float* L = FM(0);
#pragma unroll
            for (int bi = 0; bi < 4; ++bi) {
                f32x4 t4;
#pragma unroll
                for (int j = 0; j < 4; ++j) t4[j] = RH[(bi * 16 + 4 * q + j) * MS + cb + l15];
#pragma unroll
                for (int bj = 0; bj < bi; ++bj)
#pragma unroll
                    for (int kk = 0; kk < 4; ++kk) {
                        const float a = -L[(bi * 16 + l15) * MS + bj * 16 + 4 * kk + q];
                        const float b = RH[(bj * 16 + 4 * kk + q) * MS + cb + l15];
                        t4 = __builtin_amdgcn_mfma_f32_16x16x4f32(a, b, t4, 0, 0, 0);
                    }
                const f32x4 dv = *(const LAS f32x4*)(DI + (bi * 16 + l15) * 20 + 4 * q);
                f32x4 o4 = (f32x4){0.f, 0.f, 0.f, 0.f};
#pragma unroll
                for (int j = 0; j < 4; ++j) o4 = __builtin_amdgcn_mfma_f32_16x16x4f32(dv[j], t4[j], o4, 0, 0, 0);
#pragma unroll
                for (int j = 0; j < 4; ++j) RH[(bi * 16 + 4 * q + j) * MS + cb + l15] = o4[j];
            }
            LAS bf16_t* WT = (w < 4) ? BM_(0) : BM_(1);
            float v8[8];
#pragma unroll
            for (int hh = 0; hh < 2; ++hh) {
#pragma unroll
                for (int i = 0; i < 8; ++i) v8[i] = RH[(q * 16 + hh * 8 + i) * MS + cb + l15];
                *(LAS u32x4*)(WT + (cb + l15) * BS + q * 16 + hh * 8) = pack8(v8);
            }
        }
        __syncthreads();
        {
            f32x4 xp[2], xa[2], xb[2]; ZACC(xp); ZACC(xa); ZACC(xb);
            mmb(xp, BM_(0), BM_(5), mrow, nc0, q);
            mmb(xa, BM_(1), BM_(5), mrow, nc0, q);
            mmb(xb, BM_(4), BM_(6), mrow, nc0, q);
            float* Pi = Pg + (size_t)item * 4096; float* Qi = Qg + (size_t)item * 4096;
#pragma unroll
            for (int i = 0; i < 2; ++i)
#pragma unroll
                for (int j = 0; j < 4; ++j) { const int r = mt * 16 + 4 * q + j, cc = nc0 + 16 * i;
                    Pi[r * 64 + cc] = (r == cc ? misc[r] : 0.f) - xp[i][j]; Qi[r * 64 + cc] = xb[i][j] - xa[i][j]; }
            f32x4 xr[2], ya[2], yb[2]; ZACC(xr); ZACC(ya); ZACC(yb);
            mmb(xr, BM_(8), BM_(0), mrow, nc0, q);
            mmb(ya, BM_(8), BM_(1), mrow, nc0, q);
            mmb(yb, BM_(9), BM_(4), mrow, nc0, q);
            bf16_t* Ri = Rcg + (size_t)item * 4096; bf16_t* Yi = Y0g + (size_t)item * 4096;
#pragma unroll
            for (int i = 0; i < 2; ++i)
#pragma unroll
                for (int j = 0; j < 4; ++j) { const int r = mt * 16 + 4 * q + j, cc = nc0 + 16 * i;
                    Ri[r * 64 + cc] = f2bf(bf2f(BM_(3)[r * BS + cc]) - xr[i][j]); Yi[r * 64 + cc] = f2bf(yb[i][j] - ya[i][j]); }
        }
        __syncthreads();
      }
    }
}

__device__ __forceinline__ void gmlp_phase(const Ctx& C) {
    const bf16_t* zg = (const bf16_t*)(C.ws + WS_ZG); const float* lnst = (const float*)(C.ws + WS_LNST);
    const float* ln_g = C.in[19]; const float* ln_b = C.in[20]; const float* w_s = C.in[21]; const float* b_s = C.in[22];
    bf16_t* ycat = (bf16_t*)(C.ws + WS_ACTA);
    constexpr int AS = 136;
    LAS bf16_t* Aw = (LAS bf16_t*)C.lds;
    LAS bf16_t* vT = (LAS bf16_t*)(C.lds + 128 * AS * 2);
    LAS float* st = (LAS float*)(C.lds + 192 * AS * 2);
    const int tid = C.tid, lane = C.lane, w = C.wave, q = lane >> 4, l15 = lane & 15;
    const int nslots = (C.G >= 8) ? (C.G / 8) : 1;
    const int h = C.bid & 7, slot = C.bid >> 3;
    if (C.G >= 8 && slot >= nslots) return;
    for (int hh = (C.G >= 8 ? h : 0); hh < (C.G >= 8 ? h + 1 : 8); ++hh) {
        __syncthreads();
        for (int e = tid; e < 128 * 64; e += NTHR) {
            const int t = e >> 6, s2 = (e & 63) * 2;
            const f32x2 wv = *(const f32x2*)(w_s + ((size_t)hh * 128 + t) * 128 + s2);
            const unsigned pk = pk2(s2 <= t ? wv.x : 0.f, (s2 + 1) <= t ? wv.y : 0.f);
            *(LAS unsigned*)(Aw + t * AS + s2) = pk;
        }
        for (int ch = (C.G >= 8 ? slot : C.bid); ch < 128; ch += (C.G >= 8 ? nslots : C.G)) {
            const int tok0 = ch * 128;
            const int dd = tid & 63;
            bf16_t vr[16], ur[4][4]; float bsr[4]; f32x4 sta = (f32x4){0.f, 0.f, 0.f, 0.f}, stb = sta, stc = sta, std_ = sta;
#pragma unroll
            for (int i = 0; i < 16; ++i) vr[i] = zg[(size_t)(tok0 + (tid >> 6) + 8 * i) * 1024 + 512 + hh * 64 + dd];
#pragma unroll
            for (int n = 0; n < 4; ++n)
#pragma unroll
                for (int j = 0; j < 4; ++j) ur[n][j] = zg[(size_t)(tok0 + w * 16 + 4 * q + j) * 1024 + hh * 64 + n * 16 + l15];
#pragma unroll
            for (int j = 0; j < 4; ++j) bsr[j] = b_s[hh * 128 + w * 16 + 4 * q + j];
            if (tid < 128) { const f32x4* p = (const f32x4*)(lnst + (size_t)(tok0 + tid) * 16); sta = p[0]; stb = p[1]; stc = p[2]; std_ = p[3]; }
            __syncthreads();
            if (tid < 128) {
                const float s1 = ((sta[0] + sta[2]) + (stb[0] + stb[2])) + ((stc[0] + stc[2]) + (std_[0] + std_[2]));
                const float s2 = ((sta[1] + sta[3]) + (stb[1] + stb[3])) + ((stc[1] + stc[3]) + (std_[1] + std_[3]));
                const float mean = s1 * (1.0f / 512.0f); const float var = fmaxf(s2 * (1.0f / 512.0f) - mean * mean, 0.f);
                st[tid] = mean; st[128 + tid] = 1.0f / sqrtf(var + 1e-5f);
            }
            __syncthreads();
            {
                const float gg = ln_g[hh * 64 + dd], bb = ln_b[hh * 64 + dd];
#pragma unroll
                for (int i = 0; i < 16; ++i) { const int s_ = (tid >> 6) + 8 * i;
                    vT[dd * AS + s_] = f2bf((bf2f(vr[i]) - st[s_]) * st[128 + s_] * gg + bb); }
            }
            __syncthreads();
            f32x4 acc[4];
#pragma unroll
            for (int n = 0; n < 4; ++n) acc[n] = (f32x4){0.f, 0.f, 0.f, 0.f};
            for (int ks = 0; ks < 4; ++ks) {
                if (ks * 32 > w * 16 + 15) break;
                const bf16x8 a = *(const LAS bf16x8*)(Aw + (w * 16 + l15) * AS + ks * 32 + q * 8);
#pragma unroll
                for (int n = 0; n < 4; ++n) {
                    const bf16x8 b = *(const LAS bf16x8*)(vT + (n * 16 + l15) * AS + ks * 32 + q * 8);
                    acc[n] = __builtin_amdgcn_mfma_f32_16x16x32_bf16(a, b, acc[n], 0, 0, 0);
                }
            }
#pragma unroll
            for (int n = 0; n < 4; ++n)
#pragma unroll
                for (int j = 0; j < 4; ++j) {
                    const int t = w * 16 + 4 * q + j, d = n * 16 + l15;
                    ycat[(size_t)(tok0 + t) * D_ + 512 + hh * 64 + d] = f2bf(bf2f(ur[n][j]) * (acc[n][j] + bsr[j]));
                }
        }
    }
    __syncthreads();
}

template <bool BT>
__device__ __forceinline__ void mm_lds(f32x4 (&acc)[2], const LAS float* A, const LAS float* B, int mrow, int nc0, int q) {
#pragma unroll
    for (int k0 = 0; k0 < 64; k0 += 16) {
        const f32x4 a = *(const LAS f32x4*)(A + mrow * MS + k0 + 4 * q);
        f32x4 b0, b1;
        if (BT) { b0 = *(const LAS f32x4*)(B + nc0 * MS + k0 + 4 * q); b1 = *(const LAS f32x4*)(B + (nc0 + 16) * MS + k0 + 4 * q); }
        else {
#pragma unroll
            for (int j = 0; j < 4; ++j) { b0[j] = B[(k0 + 4 * q + j) * MS + nc0]; b1[j] = B[(k0 + 4 * q + j) * MS + nc0 + 16]; }
        }
#pragma unroll
        for (int j = 0; j < 4; ++j) {
            acc[0] = __builtin_amdgcn_mfma_f32_16x16x4f32(a[j], b0[j], acc[0], 0, 0, 0);
            acc[1] = __builtin_amdgcn_mfma_f32_16x16x4f32(a[j], b1[j], acc[1], 0, 0, 0);
        }
    }
}
__device__ __forceinline__ void rwkv_phase_b1(const Ctx& C, unsigned* hcnt) {
    const float* Pg = (const float*)(C.ws + WS_P); const float* Qg = (const float*)(C.ws + WS_Q);
    float* Pc = (float*)(C.ws + WS_PC); float* Qc = (float*)(C.ws + WS_QC);
    const int w = C.wave;
    const int mt = w >> 1, nt0 = (w & 1) * 2;
    for (int item = C.bid; item < 8 * NGRP; item += C.G) {
        int tid = C.tid; asm volatile("" : "+v"(tid));
        const int lane = tid & 63, q = lane >> 4, l15 = lane & 15, mrow = mt * 16 + l15, nc0 = nt0 * 16 + l15;
        const int h = item & 7, g = item >> 3;
        const int e0 = tid, e1 = tid + NTHR;
        const int r0 = e0 >> 4, c0 = (e0 & 15) * 4, r1 = e1 >> 4, c1 = (e1 & 15) * 4;
        {
            const f32x4* P4 = (const f32x4*)(Pg + (size_t)((g * GCH) * 8 + h) * 4096); const f32x4* Q4 = (const f32x4*)(Qg + (size_t)((g * GCH) * 8 + h) * 4096);
            const f32x4* N4 = (const f32x4*)(Pg + (size_t)((g * GCH + 1) * 8 + h) * 4096);
            *(LAS f32x4*)(MAT(0) + r0 * MS + c0) = P4[e0]; *(LAS f32x4*)(MAT(0) + r1 * MS + c1) = P4[e1];
            *(LAS f32x4*)(MAT(1) + r0 * MS + c0) = Q4[e0]; *(LAS f32x4*)(MAT(1) + r1 * MS + c1) = Q4[e1];
            *(LAS f32x4*)(MAT(2) + r0 * MS + c0) = N4[e0]; *(LAS f32x4*)(MAT(2) + r1 * MS + c1) = N4[e1];
        }
        __syncthreads();
        for (int cc = 1; cc < GCH; ++cc) {
            const LAS float* Pb = MAT(2 + ((cc - 1) & 1)); LAS float* Pn = MAT(2 + (cc & 1));
            const float* Qi = Qg + (size_t)((g * GCH + cc) * 8 + h) * 4096;
            f32x4 n0 = (f32x4){0.f, 0.f, 0.f, 0.f}, n1 = n0;
            if (cc + 1 < GCH) { const f32x4* N4 = (const f32x4*)(Pg + (size_t)((g * GCH + cc + 1) * 8 + h) * 4096); n0 = N4[e0]; n1 = N4[e1]; }
            float qv[2][4];
#pragma unroll
            for (int i = 0; i < 2; ++i)
#pragma unroll
                for (int j = 0; j < 4; ++j) qv[i][j] = Qi[(mt * 16 + 4 * q + j) * 64 + nc0 + 16 * i];
            f32x4 xp[2], xq[2]; ZACC(xp); ZACC(xq);
            mm_lds<false>(xp, MAT(0), Pb, mrow, nc0, q);
            mm_lds<false>(xq, MAT(1), Pb, mrow, nc0, q);
            __syncthreads();
#pragma unroll
            for (int i = 0; i < 2; ++i)
#pragma unroll
                for (int j = 0; j < 4; ++j) { const int r = mt * 16 + 4 * q + j, c2 = nc0 + 16 * i;
                    MAT(0)[r * MS + c2] = xp[i][j]; MAT(1)[r * MS + c2] = xq[i][j] + qv[i][j]; }
            if (cc + 1 < GCH) { *(LAS f32x4*)(Pn + r0 * MS + c0) = n0; *(LAS f32x4*)(Pn + r1 * MS + c1) = n1; }
            __syncthreads();
        }
        {
            f32x4* P4 = (f32x4*)(Pc + (size_t)(h * NGRP + g) * 4096); f32x4* Q4 = (f32x4*)(Qc + (size_t)(h * NGRP + g) * 4096);
            P4[e0] = *(const LAS f32x4*)(MAT(0) + r0 * MS + c0); P4[e1] = *(const LAS f32x4*)(MAT(0) + r1 * MS + c1);
            Q4[e0] = *(const LAS f32x4*)(MAT(1) + r0 * MS + c0); Q4[e1] = *(const LAS f32x4*)(MAT(1) + r1 * MS + c1);
        }
        asm volatile("s_waitcnt vmcnt(0)" ::: "memory");
        __syncthreads();
        if (threadIdx.x == 0) {
            __builtin_amdgcn_fence(__ATOMIC_RELEASE, "agent");
            asm volatile("s_waitcnt vmcnt(0)" ::: "memory");
            (void)__hip_atomic_fetch_add(hcnt + 64 * h, 1u, __ATOMIC_RELAXED, __HIP_MEMORY_SCOPE_AGENT);
        }
    }
}
__device__ __forceinline__ void rwkv_phase_b2(const Ctx& C, unsigned* hcnt) {
    const float* Pc = (const float*)(C.ws + WS_PC); const float* Qc = (const float*)(C.ws + WS_QC); float* Sg = (float*)(C.ws + WS_SG);
    const int tid = C.tid, lane = C.lane, w = C.wave, q = lane >> 4, l15 = lane & 15;
    for (int item = C.bid; item < 32; item += C.G) {
        const int h = item >> 2, rb = item & 3;
        if (hcnt) {
            if (threadIdx.x == 0) {
                unsigned sp = 0;
                while (__hip_atomic_load(hcnt + 64 * h, __ATOMIC_RELAXED, __HIP_MEMORY_SCOPE_AGENT) < (unsigned)NGRP) { __builtin_amdgcn_s_sleep(1); if (++sp > (1u << 22)) break; }
                __builtin_amdgcn_fence(__ATOMIC_ACQUIRE, "agent");
                asm volatile("s_waitcnt vmcnt(0)" ::: "memory");
            }
            __syncthreads();
        }
        for (int e = tid; e < 1024; e += NTHR) MAT(0)[(e >> 6) * MS + (e & 63)] = 0.f;
        float pv[4][16], qv[4][4];
        const size_t ob = (size_t)(h * NGRP) * 4096;
        const int poff = (4 * q) * 64 + w * 16 + l15, qoff = (rb * 16 + 4 * q) * 64 + w * 16 + l15;
        if (w < 4) {
#pragma unroll
            for (int s = 0; s < 4; ++s) {
#pragma unroll
                for (int i = 0; i < 16; ++i) pv[s][i] = Pc[ob + (size_t)s * 4096 + poff + ((i & 3) + 16 * (i >> 2)) * 64];
#pragma unroll
                for (int j = 0; j < 4; ++j) qv[s][j] = Qc[ob + (size_t)s * 4096 + qoff + j * 64];
            }
        }
        __syncthreads();
        for (int g0 = 0; g0 < NGRP; g0 += 4) {
#pragma unroll
            for (int s = 0; s < 4; ++s) {
                const int g = g0 + s; const size_t o = ob + (size_t)g * 4096;
                for (int e = tid; e < 1024; e += NTHR) Sg[o + (rb * 16 + (e >> 6)) * 64 + (e & 63)] = MAT(0)[(e >> 6) * MS + (e & 63)];
                f32x4 a0 = (f32x4){0.f, 0.f, 0.f, 0.f}, a1 = a0; float qc[4];
                if (w < 4) {
                    const LAS float* m0 = MAT(0);
#pragma unroll
                    for (int kb = 0; kb < 4; kb += 2) {
                        const f32x4 s0 = *(const LAS f32x4*)(m0 + l15 * MS + 16 * kb + 4 * q), s1 = *(const LAS f32x4*)(m0 + l15 * MS + 16 * (kb + 1) + 4 * q);
#pragma unroll
                        for (int j = 0; j < 4; ++j) {
                            a0 = __builtin_amdgcn_mfma_f32_16x16x4f32(s0[j], pv[s][4 * kb + j], a0, 0, 0, 0);
                            a1 = __builtin_amdgcn_mfma_f32_16x16x4f32(s1[j], pv[s][4 * (kb + 1) + j], a1, 0, 0, 0);
                        }
                    }
#pragma unroll
                    for (int j = 0; j < 4; ++j) qc[j] = qv[s][j];
                    if (g + 4 < NGRP) {
#pragma unroll
                        for (int i = 0; i < 16; ++i) pv[s][i] = Pc[o + 4 * 4096 + poff + ((i & 3) + 16 * (i >> 2)) * 64];
#pragma unroll
                        for (int j = 0; j < 4; ++j) qv[s][j] = Qc[o + 4 * 4096 + qoff + j * 64];
                    }
                }
                __syncthreads();
                if (w < 4) {
#pragma unroll
                    for (int j = 0; j < 4; ++j) { const int r = 4 * q + j, c2 = w * 16 + l15; MAT(0)[r * MS + c2] = a0[j] + a1[j] + qc[j]; }
                }
                __syncthreads();
            }
        }
    }
}
__device__ __forceinline__ void rwkv_phase_c(const Ctx& C) {
    const bf16_t* zr = (const bf16_t*)(C.ws + WS_ZR); const float* mu = C.in[8]; const float* gn_g = C.in[17]; const float* gn_b = C.in[18];
    const float* Pg = (const float*)(C.ws + WS_P); const float* Qg = (const float*)(C.ws + WS_Q); const bf16_t* Y0g = (const bf16_t*)(C.ws + WS_Y0);
    const bf16_t* Rcg = (const bf16_t*)(C.ws + WS_RC); const bf16_t* Gg = (const bf16_t*)(C.ws + WS_G); const float* bon = (const float*)(C.ws + WS_BON);
    const float* Sg = (const float*)(C.ws + WS_SG); bf16_t* ycat = (bf16_t*)(C.ws + WS_ACTA);
    LAS bf16_t* SH = (LAS bf16_t*)MAT(4); LAS bf16_t* SL = (LAS bf16_t*)MAT(5);
    const int w = C.wave;
    const int mt = w >> 1, nt0 = (w & 1) * 2;
    for (int item = C.bid; item < 8 * NGRP; item += C.G) {
        int tid = C.tid; asm volatile("" : "+v"(tid));
        const int lane = tid & 63, q = lane >> 4, l15 = lane & 15, mrow = mt * 16 + l15, nc0 = nt0 * 16 + l15;
        const int ci = tid & 63, tg8 = tid >> 6;
        const int h = item & 7, g = item >> 3;
        const int e0 = tid, e1 = tid + NTHR;
        const int r0 = e0 >> 4, c0 = (e0 & 15) * 4, r1 = e1 >> 4, c1 = (e1 & 15) * 4;
        const int rr8 = tid >> 3, cc8 = (tid & 7) * 8;
        {
            const f32x4* S4 = (const f32x4*)(Sg + (size_t)(h * NGRP + g) * 4096);
            const f32x4 sa = S4[e0], sb = S4[e1];
            *(LAS f32x4*)(MAT(0) + r0 * MS + c0) = sa; *(LAS f32x4*)(MAT(0) + r1 * MS + c1) = sb;
            { u32x2 hi; hi.x = pk2(sa[0], sa[1]); hi.y = pk2(sa[2], sa[3]); const f32x4 rs = sa - bflo4(hi.x, hi.y); u32x2 lo; lo.x = pk2(rs[0], rs[1]); lo.y = pk2(rs[2], rs[3]);
              *(LAS u32x2*)(SH + r0 * BS + c0) = hi; *(LAS u32x2*)(SL + r0 * BS + c0) = lo; }
            { u32x2 hi; hi.x = pk2(sb[0], sb[1]); hi.y = pk2(sb[2], sb[3]); const f32x4 rs = sb - bflo4(hi.x, hi.y); u32x2 lo; lo.x = pk2(rs[0], rs[1]); lo.y = pk2(rs[2], rs[3]);
              *(LAS u32x2*)(SH + r1 * BS + c1) = hi; *(LAS u32x2*)(SL + r1 * BS + c1) = lo; }
            const size_t io = (size_t)((g * GCH) * 8 + h) * 4096;
            const f32x4* P4 = (const f32x4*)(Pg + io);
            *(LAS f32x4*)(MAT(2) + r0 * MS + c0) = P4[e0]; *(LAS f32x4*)(MAT(2) + r1 * MS + c1) = P4[e1];
            *(LAS u32x4*)((LAS bf16_t*)MAT(6) + rr8 * BS + cc8) = ((const u32x4*)(Rcg + io))[tid];
        }
        const float gg = gn_g[h * 64 + ci], gb = gn_b[h * 64 + ci], muv = mu[1024 + h * 64 + ci];
        __syncthreads();
        for (int cc = 0; cc < GCH; ++cc) {
            const int c = g * GCH + cc, tok0 = c * 64; const size_t io = (size_t)(c * 8 + h) * 4096;
            const float* Qi = Qg + io; const bf16_t* Yi = Y0g + io;
            const LAS float* Pb = MAT(2 + (cc & 1)); const LAS bf16_t* Rb = (const LAS bf16_t*)MAT(6 + (cc & 1));
            f32x4 n0 = (f32x4){0.f, 0.f, 0.f, 0.f}, n1 = n0; u32x4 rn = (u32x4){0u, 0u, 0u, 0u};
            if (cc + 1 < GCH) { const f32x4* P4 = (const f32x4*)(Pg + io + 8 * 4096); n0 = P4[e0]; n1 = P4[e1]; rn = ((const u32x4*)(Rcg + io + 8 * 4096))[tid]; }
            float qv[2][4], yv[2][4];
#pragma unroll
            for (int i = 0; i < 2; ++i)
#pragma unroll
                for (int j = 0; j < 4; ++j) { const int r = mt * 16 + 4 * q + j, c2 = nc0 + 16 * i; qv[i][j] = Qi[r * 64 + c2]; yv[i][j] = bf2f(Yi[r * 64 + c2]); }
            float vv[8], bo[8], gt[8];
#pragma unroll
            for (int u = 0; u < 8; ++u) { const int tok = tok0 + tg8 * 8 + u; vv[u] = zshift(zr, tok, 1024 + h * 64 + ci, muv); bo[u] = bon[(size_t)tok * 8 + h]; gt[u] = bf2f(Gg[(size_t)tok * GWD_ + h * 64 + ci]); }
            f32x4 xy[2], xs[2]; ZACC(xy); ZACC(xs);
#pragma unroll
            for (int ks = 0; ks < 2; ++ks) {
                const bf16x8 a = *(const LAS bf16x8*)(Rb + mrow * BS + ks * 32 + q * 8);
                const bf16x8 h0 = *(const LAS bf16x8*)(SH + nc0 * BS + ks * 32 + q * 8), h1 = *(const LAS bf16x8*)(SH + (nc0 + 16) * BS + ks * 32 + q * 8);
                const bf16x8 l0 = *(const LAS bf16x8*)(SL + nc0 * BS + ks * 32 + q * 8), l1 = *(const LAS bf16x8*)(SL + (nc0 + 16) * BS + ks * 32 + q * 8);
                xy[0] = __builtin_amdgcn_mfma_f32_16x16x32_bf16(a, h0, xy[0], 0, 0, 0); xy[1] = __builtin_amdgcn_mfma_f32_16x16x32_bf16(a, h1, xy[1], 0, 0, 0);
                xy[0] = __builtin_amdgcn_mfma_f32_16x16x32_bf16(a, l0, xy[0], 0, 0, 0); xy[1] = __builtin_amdgcn_mfma_f32_16x16x32_bf16(a, l1, xy[1], 0, 0, 0);
            }
            mm_lds<false>(xs, MAT(0), Pb, mrow, nc0, q);
#pragma unroll
            for (int i = 0; i < 2; ++i)
#pragma unroll
                for (int j = 0; j < 4; ++j) { const int r = mt * 16 + 4 * q + j, c2 = nc0 + 16 * i; MAT(1)[r * MS + c2] = xy[i][j] + yv[i][j]; }
            __syncthreads();
#pragma unroll
            for (int i = 0; i < 2; ++i)
#pragma unroll
                for (int j = 0; j < 4; ++j) { const int r = mt * 16 + 4 * q + j, c2 = nc0 + 16 * i; const float sv = xs[i][j] + qv[i][j];
                    MAT(0)[r * MS + c2] = sv; const bf16_t hb = f2bf(sv); SH[r * BS + c2] = hb; SL[r * BS + c2] = f2bf(sv - bf2f(hb)); }
            if (cc + 1 < GCH) {
                LAS float* Pn = MAT(2 + ((cc + 1) & 1));
                *(LAS f32x4*)(Pn + r0 * MS + c0) = n0; *(LAS f32x4*)(Pn + r1 * MS + c1) = n1;
                *(LAS u32x4*)((LAS bf16_t*)MAT(6 + ((cc + 1) & 1)) + rr8 * BS + cc8) = rn;
            }
#pragma unroll
            for (int u = 0; u < 8; ++u) {
                const int t = tg8 * 8 + u, tok = tok0 + t;
                const float y = MAT(1)[t * MS + ci];
                const float mean = wave_sum(y) * (1.0f / 64.0f); const float dlt = y - mean;
                const float var = wave_sum(dlt * dlt) * (1.0f / 64.0f);
                const float yn = dlt * (1.0f / sqrtf(var + 64e-5f)) * gg + gb;
                ycat[(size_t)tok * D_ + h * 64 + ci] = f2bf((yn + bo[u] * vv[u]) * gt[u]);
            }
            __syncthreads();
        }
    }
}


__device__ __forceinline__ void phase0(const Ctx& C) {
    LAS float* scr = (LAS float*)(C.lds + C.wave * 8448);
    const int gw = C.bid * 8 + C.wave, NGW = C.G * 8, lane = C.lane;
    bf16_t* W13 = (bf16_t*)(C.ws + WS_W13A); bf16_t* W2 = (bf16_t*)(C.ws + WS_W2A); bf16_t* Win = (bf16_t*)(C.ws + WS_WIN); bf16_t* Wout = (bf16_t*)(C.ws + WS_WOUT);
    bf16_t* wdecT = (bf16_t*)(C.ws + WS_LORA); bf16_t* waaaT = wdecT + 512 * 64; bf16_t* wgateT = waaaT + 512 * 64;
    constexpr int I1 = 16 * 88, NIT = 2 * I1 + 64;
    for (int it = gw; it < NIT; it += NGW) {
        int r = it;
        if (r < 16) { transpose_item(C.in[10], 64, 512, nullptr, wdecT, 0, scr, r, lane); continue; } r -= 16;
        if (r < 16) { transpose_item(C.in[12], 64, 512, nullptr, waaaT, 0, scr, r, lane); continue; } r -= 16;
        if (r < 32) { transpose_item(C.in[13], 128, 512, nullptr, wgateT, 0, scr, r, lane); continue; } r -= 32;
        if (r < I1) { transpose_item(C.in[3], D_, FF_, C.in[2], W13, 1, scr, r, lane); continue; } r -= I1;
        transpose_item(C.in[4], D_, FF_, C.in[2], W13, 2, scr, r, lane);
    }
    const float* x = C.in[0]; bf16_t* xb = (bf16_t*)(C.ws + WS_ACTA); float* ssq = (float*)(C.ws + WS_SSQA);
    for (int row = gw; row < T_; row += 4 * NGW) {
        f32x4 v[4][4];
#pragma unroll
        for (int r = 0; r < 4; ++r) { const int rw = (row + r * NGW < T_) ? row + r * NGW : row; const f32x4* xa = (const f32x4*)(x + (size_t)rw * D_) + lane;
#pragma unroll
            for (int j = 0; j < 4; ++j) v[r][j] = xa[64 * j]; }
#pragma unroll
        for (int r = 0; r < 4; ++r) {
            const int rw = row + r * NGW; const bool has = rw < T_;
            float s = 0.f; u32x2* oa = (u32x2*)(xb + (size_t)(has ? rw : row) * D_) + lane;
#pragma unroll
            for (int j = 0; j < 4; ++j) {
                s += (v[r][j][0] * v[r][j][0] + v[r][j][1] * v[r][j][1]) + (v[r][j][2] * v[r][j][2] + v[r][j][3] * v[r][j][3]);
                if (has) { u32x2 w; w.x = pk2(v[r][j][0], v[r][j][1]); w.y = pk2(v[r][j][2], v[r][j][3]); oa[64 * j] = w; }
            }
            s = wave_sum(s);
            if (has && lane < 16) ssq[(size_t)rw * 16 + lane] = lane == 0 ? s : 0.f;
        }
    }
}
__device__ __forceinline__ void convert_mid(const Ctx& C, int vbid, int vG) {
    LAS float* scr = (LAS float*)(C.lds + C.wave * 8448);
    const int gw = vbid * 8 + C.wave, NGW = vG * 8, lane = C.lane;
    bf16_t* W2 = (bf16_t*)(C.ws + WS_W2A); bf16_t* Win = (bf16_t*)(C.ws + WS_WIN); bf16_t* Wout = (bf16_t*)(C.ws + WS_WOUT);
    constexpr int I1 = 16 * 88, I2 = 44 * 32, IO = 16 * 32, NIT = I1 + I2 + IO;
    for (int it = gw; it < NIT; it += NGW) {
        int r = it;
        if (r < I2) { transpose_item(C.in[5], FF_, D_, nullptr, W2, 0, scr, r, lane); continue; } r -= I2;
        if (r < I1) { transpose_item(C.in[7], D_, FF_, C.in[6], Win, 0, scr, r, lane); continue; } r -= I1;
        transpose_item(C.in[23], D_, D_, nullptr, Wout, 0, scr, r, lane);
    }
}
__device__ __forceinline__ void convert_w13b(const Ctx& C) {
    LAS float* scr = (LAS float*)(C.lds + C.wave * 8448);
    const int gw = C.bid * 8 + C.wave, NGW = C.G * 8, lane = C.lane;
    bf16_t* W13 = (bf16_t*)(C.ws + WS_W13B);
    constexpr int I1 = 16 * 88;
    for (int it = gw; it < 2 * I1; it += NGW) {
        if (it < I1) transpose_item(C.in[25], D_, FF_, C.in[24], W13, 1, scr, it, lane);
        else transpose_item(C.in[26], D_, FF_, C.in[24], W13, 2, scr, it - I1, lane);
    }
}
__device__ __forceinline__ void convert_late(const Ctx& C, int vbid, int vG) {
    LAS float* scr = (LAS float*)(C.lds + C.wave * 8448);
    const int gw = vbid * 8 + C.wave, NGW = vG * 8, lane = C.lane;
    bf16_t* W2 = (bf16_t*)(C.ws + WS_W2B); bf16_t* Wg = (bf16_t*)(C.ws + WS_WG); bf16_t* Wple = (bf16_t*)(C.ws + WS_WPLE);
    constexpr int I2 = 44 * 32, IG = 16 * 32, IP = 4 * 32, NIT = I2 + IG + IP;
    for (int it = gw; it < NIT; it += NGW) {
        int r = it;
        if (r < I2) { transpose_item(C.in[27], FF_, D_, nullptr, W2, 0, scr, r, lane); continue; } r -= I2;
        if (r < IG) { transpose_item(C.in[29], D_, D_, C.in[28], Wg, 0, scr, r, lane); continue; } r -= IG;
        transpose_item(C.in[30], 256, D_, nullptr, Wple, 0, scr, r, lane);
    }
    const float* p = C.in[1]; bf16_t* pb = (bf16_t*)(C.ws + WS_PB);
    for (int row = gw; row < T_ / 4; row += NGW) {
        const f32x4* xr = (const f32x4*)(p + (size_t)row * 1024) + lane; u32x2* o8 = (u32x2*)(pb + (size_t)row * 1024) + lane;
#pragma unroll
        for (int j = 0; j < 4; ++j) { const f32x4 v = xr[64 * j]; u32x2 w; w.x = pk2(v[0], v[1]); w.y = pk2(v[2], v[3]); o8[64 * j] = w; }
    }
}
__device__ __forceinline__ void final_norm(const Ctx& C) {
    const int gw = C.bid * 8 + C.wave, NGW = C.G * 8, lane = C.lane;
    const float* ssq = (const float*)(C.ws + WS_SSQA); const float* gf = C.in[31]; const bf16_t* h4 = (const bf16_t*)(C.ws + WS_H4);
    f32x4 gv[4];
#pragma unroll
    for (int j = 0; j < 4; ++j) gv[j] = ((const f32x4*)gf)[lane + 64 * j];
    for (int row = gw; row < T_; row += NGW) {
        const float rs = row_rstd(ssq, row);
        f32x4* xr = (f32x4*)(C.out + (size_t)row * D_) + lane; const u32x2* hr = (const u32x2*)(h4 + (size_t)row * D_) + lane;
#pragma unroll
        for (int j = 0; j < 4; ++j) { const u32x2 hw = hr[64 * j];
            f32x4 v = (f32x4){__uint_as_float(hw.x << 16), __uint_as_float(hw.x & 0xffff0000u), __uint_as_float(hw.y << 16), __uint_as_float(hw.y & 0xffff0000u)};
            xr[64 * j] = v * rs * gv[j]; }
    }
}

#define XB_TMO      128
#define XB_XCNT(j)  (256  + 64 * (j))
#define XB_XSUB(j)  (1280 + 64 * (j))
#define XB_XGEN(j)  (2304 + 64 * (j))
#define XB_TOP      3328
#define XB_TOPGEN   3392
#define XCD_BAR_WORDS 3456
#define XB_SPIN_CAP (1u << 18)

__device__ __forceinline__ unsigned xb_ld(unsigned* p)              { return __hip_atomic_load(p, __ATOMIC_RELAXED, __HIP_MEMORY_SCOPE_AGENT); }
__device__ __forceinline__ unsigned xb_add(unsigned* p, unsigned v) { return __hip_atomic_fetch_add(p, v, __ATOMIC_RELAXED, __HIP_MEMORY_SCOPE_AGENT); }
__device__ __forceinline__ unsigned xb_xcc_id() { return (unsigned)__builtin_amdgcn_s_getreg((3 << 11) | 20) & 0xFu; }
#define XB_SPIN(cond, bar) do { unsigned _sp = 0; while (cond) { __builtin_amdgcn_s_sleep(1); \
    if ((++_sp & 255u) == 0u) { if (xb_ld(&(bar)[XB_TMO])) break; if (_sp > XB_SPIN_CAP) { atomicAdd(&(bar)[XB_TMO], 1u); break; } } } } while (0)
struct XcdBarrier {
    unsigned* bar; unsigned x;
    volatile LAS unsigned* st;
};

__device__ __forceinline__ XcdBarrier xcd_barrier_post(unsigned* bar, volatile LAS unsigned* st) {
    XcdBarrier b; b.bar = bar; b.x = xb_xcc_id(); b.st = st;
    if (threadIdx.x == 0) (void)xb_add(&bar[XB_XCNT(b.x)], 1u);
    return b;
}
__device__ __forceinline__ void xcd_barrier_complete(unsigned* bar, unsigned x, unsigned& nloc, unsigned& nx) {
    const unsigned G = gridDim.x * gridDim.y * gridDim.z;
    unsigned sum, cnt, mine, sp = 0u;
    for (;;) {
        sum = 0u; cnt = 0u; mine = 0u;
#pragma unroll
        for (unsigned j = 0; j < 16; ++j) { const unsigned c = xb_ld(&bar[XB_XCNT(j)]); sum += c; cnt += (c > 0u) ? 1u : 0u; mine = (j == x) ? c : mine; }
        if (sum == G) break;
        __builtin_amdgcn_s_sleep(1);
        if ((++sp & 255u) == 0u) { if (xb_ld(&bar[XB_TMO])) break; if (sp > XB_SPIN_CAP) { atomicAdd(&bar[XB_TMO], 1u); break; } }
    }
    nloc = mine > 0u ? mine : 1u; nx = cnt > 0u ? cnt : 1u;
}

__device__ __forceinline__ void xcd_barrier(const XcdBarrier& b) {
    asm volatile("s_waitcnt vmcnt(0)" ::: "memory");
    __syncthreads();
    if (threadIdx.x == 0) {
        unsigned* bar = b.bar;
        __builtin_amdgcn_s_waitcnt(0);
        unsigned nloc = b.st[0], nx = b.st[1];
        if (nloc == 0u) { xcd_barrier_complete(bar, b.x, nloc, nx); b.st[0] = nloc; b.st[1] = nx; }
        const unsigned old = xb_add(&bar[XB_XSUB(b.x)], 1u);
        const unsigned gen = old / nloc;
        if (old + 1u == (gen + 1u) * nloc) {
            __builtin_amdgcn_fence(__ATOMIC_RELEASE, "agent");
            asm volatile("s_waitcnt vmcnt(0)" ::: "memory");
            const unsigned og = xb_add(&bar[XB_TOP], 1u);
            const unsigned tg = og / nx;
            if (og + 1u == (tg + 1u) * nx) xb_add(&bar[XB_TOPGEN], 1u);
            else XB_SPIN(xb_ld(&bar[XB_TOPGEN]) == tg, bar);
            __builtin_amdgcn_fence(__ATOMIC_ACQUIRE, "agent");
            xb_add(&bar[XB_XGEN(b.x)], 1u);
            asm volatile("s_waitcnt vmcnt(0)" ::: "memory");
        } else {
            XB_SPIN(xb_ld(&bar[XB_XGEN(b.x)]) == gen, bar);
            __builtin_amdgcn_fence(__ATOMIC_ACQUIRE, "agent");
            asm volatile("s_waitcnt vmcnt(0)" ::: "memory");
        }
    }
    __syncthreads();
}

constexpr size_t WS_BAR = 255 * MiB;
constexpr int ST_OFF = LDS_BYTES - 16;

#ifndef X_RESID_BF16
#define X_RESID_BF16 1
#endif
#ifndef KEEP_LO1
#define KEEP_LO1 false
#endif
#ifndef KEEP_LO2
#define KEEP_LO2 false
#endif
#ifndef KEEP_LO3
#define KEEP_LO3 false
#endif
struct Args { const float* in[32]; float* out; unsigned char* ws; int ph_lo, ph_hi, flags, pad; };

__global__ void __launch_bounds__(NTHR, 2) fwd_kernel(Args args) {
    __builtin_assume(__builtin_amdgcn_workitem_id_y() == 0); __builtin_assume(__builtin_amdgcn_workitem_id_z() == 0);
    extern __shared__ __attribute__((aligned(16))) unsigned char lds_raw[];
    cg::grid_group grid = cg::this_grid();
    Ctx C;
    C.lds = (LAS unsigned char*)lds_raw; C.tid = threadIdx.x; C.lane = C.tid & 63; C.wave = __builtin_amdgcn_readfirstlane(C.tid >> 6);
    C.G = gridDim.x; C.bid = blockIdx.x; C.in = args.in; C.out = args.out; C.ws = args.ws;
    const int lo = args.ph_lo, hi = args.ph_hi;
    if (threadIdx.x < 4) ((LAS unsigned*)(C.lds + ST_OFF))[threadIdx.x] = 0u;
    __syncthreads();
    XcdBarrier xbar = xcd_barrier_post((unsigned*)(args.ws + WS_BAR), (volatile LAS unsigned*)(C.lds + ST_OFF));
    unsigned char* ws = args.ws;
    bf16_t* actA = (bf16_t*)(ws + WS_ACTA); bf16_t* actB = (bf16_t*)(ws + WS_ACTB); bf16_t* hid = (bf16_t*)(ws + WS_HID);
    float* ssqA = (float*)(ws + WS_SSQA); float* ssqB = (float*)(ws + WS_SSQB);
    bf16_t* hlo3 = (bf16_t*)(ws + 184 * MiB);
    bf16_t* hlo = (bf16_t*)args.out;
    bf16_t* hhi1 = hlo + (size_t)T_ * D_;
#define IN(k) (lo <= (k) && (k) < hi)
#define SEAM(k) do { if (IN(k) && IN((k) + 1)) xcd_barrier(xbar); } while (0)

    if (IN(0)) { phase0(C); } SEAM(0);
    if (IN(1)) {
        pg8::Gemm g{actA, (const bf16_t*)(ws + WS_W13A), T_, 2 * FF_, D_}; pg8::StaticOrder S; S.init(T_, 2 * FF_, C.G, C.bid);
        EpiSwiGLU E{hid, ssqA};
        pg8::gemm_phase<EpiSwiGLU, pg8::StaticOrder, true, true>(C.lds, g, S, E);
        { const int rem = S.nwg % C.G; __syncthreads(); if (rem == 0) convert_mid(C, C.bid, C.G); else if (C.bid >= rem) convert_mid(C, C.bid - rem, C.G - rem); }
    } SEAM(1);
    if (IN(2)) {
        pg8::Gemm g{hid, (const bf16_t*)(ws + WS_W2A), T_, D_, FF_}; pg8::StaticOrder S; S.init(T_, D_, C.G, C.bid);
#if X_RESID_BF16
        EpiResid<1, false, KEEP_LO1> E{nullptr, actA, nullptr, hlo, hhi1, ssqB, 0.5f};
        pg8::gemm_phase<EpiResid<1, false, KEEP_LO1>, pg8::StaticOrder, false, true>(C.lds, g, S, E);
#else
        EpiResid<0, false, KEEP_LO1> E{args.in[0], nullptr, nullptr, hlo, hhi1, ssqB, 0.5f};
        pg8::gemm_phase<EpiResid<0, false, KEEP_LO1>, pg8::StaticOrder, false, true>(C.lds, g, S, E);
#endif
    } SEAM(2);
    if (IN(3)) {
        pg8::Gemm g{hhi1, (const bf16_t*)(ws + WS_WIN), T_, FF_, D_}; pg8::StaticOrder S; S.init(T_, FF_, C.G, C.bid);
        EpiZ E{(bf16_t*)(ws + WS_ZR), (bf16_t*)(ws + WS_ZG), ssqB, (float*)(ws + WS_LNST)};
        pg8::gemm_phase<EpiZ, pg8::StaticOrder, true, true>(C.lds, g, S, E);
    } SEAM(3);
    if (IN(4)) { rwkv_phase_a(C); } SEAM(4);
    unsigned* hcnt = (unsigned*)(ws + WS_BAR + 32768);
    const bool chain56 = IN(5) && IN(6);
    if (IN(5)) { rwkv_phase_b1(C, hcnt); } if (!chain56) SEAM(5);
    if (IN(6)) {
        if (C.G >= 64) { if (C.bid < 32) rwkv_phase_b2(C, chain56 ? hcnt : nullptr); else { Ctx C2 = C; C2.bid = C.bid - 32; C2.G = C.G - 32; gmlp_phase(C2); } }
        else { rwkv_phase_b2(C, chain56 ? hcnt : nullptr); __syncthreads(); gmlp_phase(C); }
    } SEAM(6);
    if (IN(7)) { rwkv_phase_c(C); } SEAM(7);
    if (IN(8)) {
        convert_w13b(C); __syncthreads();
        pg8::Gemm g{actA, (const bf16_t*)(ws + WS_WOUT), T_, D_, D_}; pg8::StaticOrder S; S.init(T_, D_, C.G, C.bid);
        EpiResid<1, KEEP_LO1, KEEP_LO2> E{nullptr, hhi1, hlo, hlo, actB, ssqA, 1.0f};
        pg8::gemm_phase<EpiResid<1, KEEP_LO1, KEEP_LO2>, pg8::StaticOrder, false, true>(C.lds, g, S, E);
    } SEAM(8);
    if (IN(9)) {
        pg8::Gemm g{actB, (const bf16_t*)(ws + WS_W13B), T_, 2 * FF_, D_}; pg8::StaticOrder S; S.init(T_, 2 * FF_, C.G, C.bid);
        EpiSwiGLU E{hid, ssqA};
        pg8::gemm_phase<EpiSwiGLU, pg8::StaticOrder, true, true>(C.lds, g, S, E);
        { const int rem = S.nwg % C.G; __syncthreads(); if (rem == 0) convert_late(C, C.bid, C.G); else if (C.bid >= rem) convert_late(C, C.bid - rem, C.G - rem); }
    } SEAM(9);
    if (IN(10)) {
        pg8::Gemm g{hid, (const bf16_t*)(ws + WS_W2B), T_, D_, FF_}; pg8::StaticOrder S; S.init(T_, D_, C.G, C.bid);
        EpiResid<1, KEEP_LO2, KEEP_LO3> E{nullptr, actB, hlo, hlo3, actA, ssqB, 0.5f};
        pg8::gemm_phase<EpiResid<1, KEEP_LO2, KEEP_LO3>, pg8::StaticOrder, false, true>(C.lds, g, S, E);
    } SEAM(10);
    const bool fuse_final = (64 * 4 == C.G);
    if (IN(11)) {
        { pg8::Gemm g{(const bf16_t*)(ws + WS_PB), (const bf16_t*)(ws + WS_WPLE), T_, D_, 256}; pg8::StaticOrder S; S.init(T_, D_, C.G, C.bid);
          EpiPE E{(bf16_t*)(ws + WS_PE)};
          pg8::gemm_phase<EpiPE, pg8::StaticOrder, false, true>(C.lds, g, S, E); }
        __syncthreads();
        if (fuse_final) {
          pg8::Gemm g{actA, (const bf16_t*)(ws + WS_WG), T_, D_, D_}; pg8::StaticOrder S; S.init(T_, D_, C.G, C.bid);
          EpiGateFinal E{(const bf16_t*)(ws + WS_PE), actA, KEEP_LO3 ? hlo3 : nullptr, args.out, args.in[31], ssqB, ssqA, (unsigned*)(ws + WS_BAR + 16384)};
          pg8::gemm_phase<EpiGateFinal, pg8::StaticOrder, false, true>(C.lds, g, S, E);
        } else {
          pg8::Gemm g{actA, (const bf16_t*)(ws + WS_WG), T_, D_, D_}; pg8::StaticOrder S; S.init(T_, D_, C.G, C.bid);
          EpiGate E{(const bf16_t*)(ws + WS_PE), actA, KEEP_LO3 ? hlo3 : nullptr, (bf16_t*)(ws + WS_H4), ssqB, ssqA};
          pg8::gemm_phase<EpiGate, pg8::StaticOrder, false, true>(C.lds, g, S, E);
        }
    }
    if (!fuse_final) SEAM(11);
    if (IN(12) && !fuse_final) { final_norm(C); }
    if (hi > 64) grid.sync();
#undef IN
#undef SEAM
}

extern "C" void kernel_launch(void* const* d_in, const int* in_sizes, int n_in, void* d_out, int out_size, void* d_ws, size_t ws_size, hipStream_t stream) {
    static int grid = 0;
    if (grid == 0) {
        int dev = 0, cus = 0, per_cu = 0;
        hipGetDevice(&dev);
        hipDeviceGetAttribute(&cus, hipDeviceAttributeMultiprocessorCount, dev);
        if (hipFuncSetAttribute((const void*)fwd_kernel, hipFuncAttributeMaxDynamicSharedMemorySize, LDS_BYTES) != hipSuccess) fprintf(stderr, "hipFuncSetAttribute failed\n");
        hipOccupancyMaxActiveBlocksPerMultiprocessor(&per_cu, (const void*)fwd_kernel, NTHR, LDS_BYTES);
        if (per_cu < 1) { fprintf(stderr, "occupancy query says %d blocks/CU\n", per_cu); per_cu = 1; }
        if (per_cu > 1) per_cu = 1;
        grid = cus * per_cu;
        (void)hipGetLastError();
        if (ws_size < 254 * MiB) fprintf(stderr, "workspace too small: %zu\n", ws_size);
    }
    (void)hipMemsetAsync((char*)d_ws + WS_BAR, 0, 32768 + 2048, stream);
    Args a{};
    for (int i = 0; i < 32; ++i) a.in[i] = (const float*)d_in[i];
    a.out = (float*)d_out; a.ws = (unsigned char*)d_ws;
#if defined(MK_MULTI)
    for (int ph = 0; ph < 13; ++ph) { a.ph_lo = ph; a.ph_hi = ph + 1; hipLaunchKernelGGL(fwd_kernel, dim3(grid), dim3(NTHR), LDS_BYTES, stream, a); }
#else
    a.ph_lo = 0; a.ph_hi = 13;
    void* kargs[] = {&a};
    hipError_t e = hipLaunchCooperativeKernel((const void*)fwd_kernel, dim3(grid), dim3(NTHR), kargs, LDS_BYTES, stream);
    if (e != hipSuccess) fprintf(stderr, "cooperative launch failed: %s (grid %d)\n", hipGetErrorString(e), grid);
#if defined(PROBE_PHASES)
    a.flags = PROBE_FLAGS; for (int ph = 0; ph < 13; ++ph) if ((PROBE_PHASES >> ph) & 1) { a.ph_lo = ph; a.ph_hi = ph + 1; hipLaunchKernelGGL(fwd_kernel, dim3(grid), dim3(NTHR), LDS_BYTES, stream, a); }
#endif
#endif
}
```

```cpp
#include <hip/hip_runtime.h>
#include <hip/hip_cooperative_groups.h>
#include <cstdio>
#include <cstdint>
namespace cg = cooperative_groups;

namespace pg8 {
#define PG8_LAS __attribute__((address_space(3)))
typedef unsigned short bf16_t;
typedef short bf16x8 __attribute__((ext_vector_type(8)));
typedef float f32x4 __attribute__((ext_vector_type(4)));
typedef unsigned u32x4 __attribute__((ext_vector_type(4)));
constexpr int BM = 256, BK = 64, HALF = 128, HTB = HALF * BK * 2  , STAGE_BYTES = 8 * HTB, NXCD = 8, WGM = 8;

__host__ __device__ __forceinline__ int lds_byte(int r, int c) { const int st = (r >> 4) * 2 + (c >> 5), rr = r & 15, cc = c & 31, ob = rr * 64 + cc * 2; return st * 1024 + (ob ^ (((ob >> 9) & 1) << 5)); }
__host__ __device__ __forceinline__ void stage_rc(int b, int& R, int& C) { const int st = b / 1024, sb = b % 1024, swz = sb ^ (((sb >> 9) & 1) << 5); R = (st >> 1) * 16 + swz / 64; C = (st & 1) * 32 + (swz % 64) / 2; }
__host__ __device__ __forceinline__ int perm32(int rho) { const int n = rho >> 4, i = rho & 15; return 8 * (i >> 2) + 4 * n + (i & 3); }

struct Unit { int pm, pn; };
struct Gemm { const bf16_t* A; const bf16_t* Bt; int M, N, K; };

struct StaticOrder {
    int nM, nN, nwg, G, c;
    __host__ __device__ void init(int M, int N, int G_, int c_) { nM = M / BM; nN = N / BM; nwg = nM * nN; G = G_; c = c_; }
    __host__ __device__ bool next(int i, Unit& u) const {
        const long L = (long)i * G + c; if (L >= nwg) return false;
        int wgid = (int)L; { const int q = nwg / NXCD, r = nwg % NXCD, xcd = wgid % NXCD, off = wgid / NXCD; wgid = (xcd < r ? xcd * (q + 1) : r * (q + 1) + (xcd - r) * q) + off; }
        const int nig = WGM * nN, gid = wgid / nig, fm = gid * WGM, gsz = (nM - fm) < WGM ? (nM - fm) : WGM;
        u.pm = fm + ((wgid % nig) % gsz); u.pn = (wgid % nig) / gsz; return true;
    }
    __device__ __forceinline__ void a_ready(const Unit&) const {}
    __device__ __forceinline__ void done(const Unit&) const {}
};

__device__ __forceinline__ unsigned cvt_pk_bf16(float lo, float hi) { unsigned r; asm volatile("v_cvt_pk_bf16_f32 %0, %1, %2" : "=v"(r) : "v"(lo), "v"(hi)); return r; }
template <class Epi, class Sched, bool ALIGN_EPI = false, bool SP2 = false>
__device__ __forceinline__ void gemm_phase(PG8_LAS unsigned char* lds, const Gemm g, const Sched& S, const Epi& E) {
    const int tid = threadIdx.x, wid = __builtin_amdgcn_readfirstlane(tid >> 6), lane = tid & 63, wr = wid >> 2, wc = wid & 3, fr = lane & 15, fq = lane >> 4;
    const int K = g.K, nt = K / BK;
    unsigned voffA[2], voffB[2];
#pragma unroll
    for (int i = 0; i < 2; ++i) { int R, C; stage_rc(tid * 16 + i * 8192, R, C); const int Rb = Epi::PERM ? ((R & ~31) + perm32(R & 31)) : R;
        voffA[i] = (unsigned)(R * K + C) * 2u; voffB[i] = (unsigned)(Rb * K + C) * 2u; }
    const size_t kstep = (size_t)(BK * 2);
    const size_t hstep = (size_t)HALF * K * 2;
    const size_t tstep = 2 * hstep;
    const unsigned ldsw = (unsigned)wid * 1024u;
    const int aoff = lds_byte(wr * 64 + fr, fq * 8), boff = lds_byte(wc * 32 + fr, fq * 8);
#define PG8_SA(b, h) (((b) * 2 + (h)) * HTB)
#define PG8_SB(b, h) ((4 + (b) * 2 + (h)) * HTB)
#define PG8_STAGE(bufoff, gbase, voff) do { _Pragma("unroll") for (int _i = 0; _i < 2; ++_i) \
        __builtin_amdgcn_global_load_lds((const unsigned*)((const char*)(gbase) + (voff)[_i]), (PG8_LAS unsigned*)(lds + (bufoff) + ldsw + _i * 8192), 16, 0, 0); } while (0)
#define PG8_LDA(dst, b, h) do { _Pragma("unroll") for (int m = 0; m < 4; ++m) _Pragma("unroll") for (int k = 0; k < 2; ++k) dst[m][k] = *(const PG8_LAS bf16x8*)(lds + PG8_SA(b, h) + aoff + m * 2048 + k * 1024); } while (0)
#define PG8_LDB(dst, b, h) do { _Pragma("unroll") for (int n = 0; n < 2; ++n) _Pragma("unroll") for (int k = 0; k < 2; ++k) dst[n][k] = *(const PG8_LAS bf16x8*)(lds + PG8_SB(b, h) + boff + n * 2048 + k * 1024); } while (0)
#define PG8_MMA(ai, bj, At, Bt) do { __builtin_amdgcn_s_setprio(1); _Pragma("unroll") for (int m = 0; m < 4; ++m) _Pragma("unroll") for (int n = 0; n < 2; ++n) _Pragma("unroll") for (int k = 0; k < 2; ++k) \
        acc[ai][bj][m][n] = __builtin_amdgcn_mfma_f32_16x16x32_bf16(Bt[n][k], At[m][k], acc[ai][bj][m][n], 0, 0, 0); __builtin_amdgcn_s_setprio(0); } while (0)
#define PG8_WAIT_V(n) asm volatile("s_waitcnt vmcnt(" #n ")" ::: "memory")
#define PG8_WAIT_L(n) asm volatile("s_waitcnt lgkmcnt(" #n ")" ::: "memory")
#define PG8_BAR __builtin_amdgcn_s_barrier()
#define PG8_SCHED __builtin_amdgcn_sched_barrier(0)
    Unit cur, nxt; int ui = 0;
    if (!S.next(0, cur)) return;
    f32x4 acc[2][2][4][2];
#pragma unroll
    for (int a = 0; a < 2; ++a)
#pragma unroll
        for (int b = 0; b < 2; ++b)
#pragma unroll
            for (int m = 0; m < 4; ++m)
#pragma unroll
                for (int n = 0; n < 2; ++n) acc[a][b][m][n] = (f32x4){0.f, 0.f, 0.f, 0.f};
    bf16x8 At[4][2], B0[2][2], B1[2][2];
    const char* cA = (const char*)g.A + (size_t)cur.pm * tstep; const char* cB = (const char*)g.Bt + (size_t)cur.pn * tstep;
    S.a_ready(cur);
    if constexpr (SP2) {
        PG8_STAGE(PG8_SB(0, 0), cB, voffB); PG8_STAGE(PG8_SB(0, 1), cB + hstep, voffB); PG8_STAGE(PG8_SA(0, 0), cA, voffA); PG8_STAGE(PG8_SA(0, 1), cA + hstep, voffA);
        if (wr == 1) PG8_BAR;
        PG8_WAIT_V(2); PG8_BAR;
        PG8_STAGE(PG8_SB(1, 0), cB + kstep, voffB); PG8_STAGE(PG8_SA(1, 0), cA + kstep, voffA); PG8_STAGE(PG8_SB(1, 1), cB + hstep + kstep, voffB);
        PG8_WAIT_V(6); PG8_BAR;
    } else {
        PG8_STAGE(PG8_SB(0, 0), cB, voffB); PG8_STAGE(PG8_SA(0, 0), cA, voffA); PG8_STAGE(PG8_SB(0, 1), cB + hstep, voffB); PG8_STAGE(PG8_SA(0, 1), cA + hstep, voffA);
        if (wr == 1) PG8_BAR;
        PG8_WAIT_V(4); PG8_BAR;
        PG8_STAGE(PG8_SB(1, 0), cB + kstep, voffB); PG8_STAGE(PG8_SA(1, 0), cA + kstep, voffA); PG8_STAGE(PG8_SB(1, 1), cB + hstep + kstep, voffB);
        PG8_WAIT_V(6); PG8_BAR;
    }
    for (;;) {
        const bool has_next = S.next(ui + 1, nxt);
        const char* nA = has_next ? (const char*)g.A + (size_t)nxt.pm * tstep : cA; const char* nB = has_next ? (const char*)g.Bt + (size_t)nxt.pn * tstep : cB;
        for (int t = 0; t < nt; t += 2) {
            const bool last = (t == nt - 2);
            const char* a1 = cA + (size_t)(t + 1) * kstep;
            const char* a2 = last ? nA : cA + (size_t)(t + 2) * kstep; const char* b2 = last ? nB : cB + (size_t)(t + 2) * kstep;
            const char* a3 = a2 + kstep; const char* b3 = b2 + kstep;
            if (last && has_next) S.a_ready(nxt);
            if constexpr (SP2) {
            PG8_LDB(B0, 0, 0); PG8_LDB(B1, 0, 1); PG8_SCHED; PG8_LDA(At, 0, 0); PG8_STAGE(PG8_SA(1, 1), a1 + hstep, voffA);
            PG8_WAIT_V(8); PG8_WAIT_L(0); PG8_BAR; PG8_MMA(0, 0, At, B0); PG8_MMA(0, 1, At, B1); PG8_BAR; PG8_SCHED;
            PG8_LDA(At, 0, 1); PG8_STAGE(PG8_SB(0, 0), b2, voffB); PG8_STAGE(PG8_SB(0, 1), b2 + hstep, voffB); PG8_STAGE(PG8_SA(0, 0), a2, voffA);
            PG8_WAIT_V(8); PG8_WAIT_L(0); PG8_BAR; PG8_MMA(1, 0, At, B0); PG8_MMA(1, 1, At, B1); PG8_BAR; PG8_SCHED;
            PG8_LDB(B0, 1, 0); PG8_LDB(B1, 1, 1); PG8_SCHED; PG8_LDA(At, 1, 0); PG8_STAGE(PG8_SA(0, 1), a2 + hstep, voffA);
            PG8_WAIT_V(8); PG8_WAIT_L(0); PG8_BAR; PG8_MMA(0, 0, At, B0); PG8_MMA(0, 1, At, B1); PG8_BAR; PG8_SCHED;
            PG8_LDA(At, 1, 1); PG8_STAGE(PG8_SB(1, 0), b3, voffB); PG8_STAGE(PG8_SB(1, 1), b3 + hstep, voffB); PG8_STAGE(PG8_SA(1, 0), a3, voffA);
            PG8_WAIT_V(8); PG8_WAIT_L(0); PG8_BAR; PG8_MMA(1, 0, At, B0); PG8_MMA(1, 1, At, B1); PG8_BAR; PG8_SCHED;
            } else {
            PG8_LDB(B0, 0, 0); PG8_SCHED; PG8_LDA(At, 0, 0); PG8_STAGE(PG8_SA(1, 1), a1 + hstep, voffA);
            PG8_WAIT_L(8); PG8_BAR; PG8_WAIT_L(0); PG8_MMA(0, 0, At, B0); PG8_BAR; PG8_SCHED;
            PG8_LDB(B1, 0, 1); PG8_STAGE(PG8_SB(0, 0), b2, voffB);
            PG8_BAR; PG8_WAIT_L(0); PG8_MMA(0, 1, At, B1); PG8_BAR;
            PG8_LDA(At, 0, 1); PG8_STAGE(PG8_SA(0, 0), a2, voffA);
            PG8_BAR; PG8_WAIT_L(0); PG8_MMA(1, 0, At, B0); PG8_BAR; PG8_SCHED;
            PG8_STAGE(PG8_SB(0, 1), b2 + hstep, voffB);
            PG8_WAIT_V(6); PG8_BAR; PG8_MMA(1, 1, At, B1); PG8_BAR;
            PG8_LDB(B0, 1, 0); PG8_SCHED; PG8_LDA(At, 1, 0); PG8_STAGE(PG8_SA(0, 1), a2 + hstep, voffA);
            PG8_WAIT_L(8); PG8_BAR; PG8_WAIT_L(0); PG8_MMA(0, 0, At, B0); PG8_BAR; PG8_SCHED;
            PG8_LDB(B1, 1, 1); PG8_STAGE(PG8_SB(1, 0), b3, voffB);
            PG8_BAR; PG8_WAIT_L(0); PG8_MMA(0, 1, At, B1); PG8_BAR;
            PG8_LDA(At, 1, 1); PG8_STAGE(PG8_SA(1, 0), a3, voffA);
            PG8_BAR; PG8_WAIT_L(0); PG8_MMA(1, 0, At, B0); PG8_BAR; PG8_SCHED;
            PG8_STAGE(PG8_SB(1, 1), b3 + hstep, voffB);
            PG8_WAIT_V(6); PG8_BAR; PG8_MMA(1, 1, At, B1); PG8_BAR;
            }
        }
        if constexpr (ALIGN_EPI) { if (wr == 0) PG8_BAR; }
        if constexpr (!Epi::AFTER_DRAIN) { E(acc, cur, wr, wc, fr, fq); S.done(cur); }
        if (!has_next) break;
#pragma unroll
        for (int a = 0; a < 2; ++a)
#pragma unroll
            for (int b = 0; b < 2; ++b)
#pragma unroll
                for (int m = 0; m < 4; ++m)
#pragma unroll
                    for (int n = 0; n < 2; ++n) acc[a][b][m][n] = (f32x4){0.f, 0.f, 0.f, 0.f};
        cur = nxt; cA = nA; cB = nB; ++ui;
        if constexpr (ALIGN_EPI) { if (wr == 1) PG8_BAR; }
    }
    PG8_WAIT_V(0);
    if constexpr (!ALIGN_EPI) { if (wr == 0) PG8_BAR; }
    PG8_BAR;
    if constexpr (Epi::AFTER_DRAIN) { E.fused(acc, cur, wr, wc, fr, fq, lds, wid, lane); S.done(cur); }
#undef PG8_SA
#undef PG8_SB
#undef PG8_STAGE
#undef PG8_LDA
#undef PG8_LDB
#undef PG8_MMA
#undef PG8_WAIT_V
#undef PG8_WAIT_L
#undef PG8_BAR
#undef PG8_SCHED
}
}

using pg8::bf16_t; using pg8::bf16x8; using pg8::f32x4; using pg8::u32x4; using pg8::Unit;
#define LAS __attribute__((address_space(3)))
typedef unsigned u32x2 __attribute__((ext_vector_type(2)));
typedef float f32x2 __attribute__((ext_vector_type(2)));

constexpr int T_ = 16384, D_ = 1024, FF_ = 2816, RC_ = 1792, NTHR = 512, GWD_ = 512;
constexpr int LDS_BYTES = 163840;
constexpr int MS = 68;
constexpr int MBYTES = 64 * MS * 4;
constexpr int MISC_OFF = 9 * MBYTES;
constexpr int NCH = 256, NGRP = 32, GCH = 8;

constexpr size_t MiB = 1ull << 20;
constexpr size_t WS_HID = 0, WS_ZR = 0, WS_ZG = 56 * MiB, WS_PE = 0, WS_H4 = 32 * MiB;
constexpr size_t WS_ACTA = 88 * MiB, WS_ACTB = 120 * MiB;
constexpr size_t WS_W13A = 152 * MiB, WS_W2A = 163 * MiB, WS_WIN = 163 * MiB + 512 * 1024 * 11, WS_WOUT = 252 * MiB;
constexpr size_t WS_P = 120 * MiB, WS_Q = 152 * MiB, WS_Y0 = 184 * MiB, WS_RC = 200 * MiB, WS_G = 216 * MiB;
constexpr size_t WS_PC = 232 * MiB, WS_QC = 236 * MiB, WS_SG = 240 * MiB, WS_BON = 244 * MiB, WS_LNST = 245 * MiB;
constexpr size_t WS_SSQA = 246 * MiB, WS_SSQB = 247 * MiB;
constexpr size_t WS_W13B = 152 * MiB, WS_W2B = 163 * MiB, WS_WG = 163 * MiB + 512 * 1024 * 11, WS_WPLE = 171 * MiB, WS_PB = 172 * MiB;

typedef __bf16 bf16x2_t __attribute__((ext_vector_type(2)));
__device__ __forceinline__ unsigned pk2(float lo, float hi) { const f32x2 v = {lo, hi}; const bf16x2_t b = __builtin_convertvector(v, bf16x2_t); return __builtin_bit_cast(unsigned, b); }
__device__ __forceinline__ float bf2f(bf16_t b) { return __uint_as_float(((unsigned)b) << 16); }
__device__ __forceinline__ bf16_t f2bf(float f) { return (bf16_t)(pk2(f, 0.f) & 0xffffu); }
__device__ __forceinline__ float dpp_f(float v, const int ctrl_sel) {
    int i = __float_as_int(v), r;
    if (ctrl_sel == 0) r = __builtin_amdgcn_update_dpp(i, i, 0xB1, 0xF, 0xF, false);
    else if (ctrl_sel == 1) r = __builtin_amdgcn_update_dpp(i, i, 0x4E, 0xF, 0xF, false);
    else if (ctrl_sel == 2) r = __builtin_amdgcn_update_dpp(i, i, 0x141, 0xF, 0xF, false);
    else r = __builtin_amdgcn_update_dpp(i, i, 0x140, 0xF, 0xF, false);
    return __int_as_float(r);
}
__device__ __forceinline__ float wave_sum(float v) {
    v += dpp_f(v, 0); v += dpp_f(v, 1); v += dpp_f(v, 2); v += dpp_f(v, 3);
    const int vi = __float_as_int(v);
    const float s0 = __int_as_float(__builtin_amdgcn_readlane(vi, 0)), s1 = __int_as_float(__builtin_amdgcn_readlane(vi, 16)), s2 = __int_as_float(__builtin_amdgcn_readlane(vi, 32)), s3 = __int_as_float(__builtin_amdgcn_readlane(vi, 48));
    return (s0 + s1) + (s2 + s3);
}
__device__ __forceinline__ float row_rstd(const float* ssq, int row) {
    const f32x4* p = (const f32x4*)(ssq + (size_t)row * 16);
    const f32x4 a = p[0], b = p[1], c = p[2], d = p[3];
    const float s = (((a[0] + a[1]) + (a[2] + a[3])) + ((b[0] + b[1]) + (b[2] + b[3]))) + (((c[0] + c[1]) + (c[2] + c[3])) + ((d[0] + d[1]) + (d[2] + d[3])));
    return 1.0f / sqrtf(s * (1.0f / 1024.0f) + 1e-6f);
}
__device__ __forceinline__ float row_rstd_q(const float* ssq, int row, int fq) {
    const f32x4 a = ((const f32x4*)(ssq + (size_t)row * 16))[fq];
    float s = (a[0] + a[1]) + (a[2] + a[3]);
    s += __shfl_xor(s, 16); s += __shfl_xor(s, 32);
    return 1.0f / sqrtf(s * (1.0f / 1024.0f) + 1e-6f);
}
__device__ __forceinline__ float frcp(float x) { return __builtin_amdgcn_rcpf(x); }
__device__ __forceinline__ float gelu_erf(float v) {
    const float av = fabsf(v), t = frcp(av * 0.2316418882f + 1.0f);
    float qq = t * 0.5307027145f + (-0.7265760135f); qq = qq * t + 0.7107068705f; qq = qq * t + (-0.142248368f); qq = qq * t + 0.127414796f; qq = qq * t;
    const float e = __builtin_amdgcn_exp2f((v * v) * (-0.72134752044f));
    const float m = v * (qq * e);
    return v < 0.f ? m : v - m;
}
__device__ __forceinline__ float sigmoidf_(float x) { return frcp(1.0f + __expf(-x)); }
__device__ __forceinline__ float tanhf_(float x) { return 1.0f - 2.0f * frcp(1.0f + __expf(2.0f * x)); }

struct EpiSwiGLU {
    static constexpr bool PERM = true, AFTER_DRAIN = false;
    bf16_t* O; const float* ssq;
    __device__ __forceinline__ void operator()(const f32x4 (&acc)[2][2][4][2], const Unit& u, int wr, int wc, int fr, int fq) const {
        const int row0 = u.pm * 256 + wr * 64 + fr, col0 = u.pn * 128 + wc * 32 + 8 * fq;
#pragma unroll
        for (int ai = 0; ai < 2; ++ai)
#pragma unroll
            for (int m = 0; m < 4; ++m) {
                const int row = row0 + ai * 128 + m * 16; const float rs = row_rstd_q(ssq, row, fq);
                float h[8];
#pragma unroll
                for (int n = 0; n < 2; ++n) {
                    const f32x4 a = acc[ai][0][m][n] * rs, b = acc[ai][1][m][n] * rs;
#pragma unroll
                    for (int j = 0; j < 4; ++j) h[4 * n + j] = a[j] * frcp(1.0f + __expf(-a[j])) * b[j];
                }
                u32x4 w; w.x = pk2(h[0], h[1]); w.y = pk2(h[2], h[3]); w.z = pk2(h[4], h[5]); w.w = pk2(h[6], h[7]);
                *(u32x4*)(O + (size_t)row * FF_ + col0) = w;
            }
    }
};
__device__ __forceinline__ f32x4 bflo4(unsigned a, unsigned b) { return (f32x4){__uint_as_float(a << 16), __uint_as_float(a & 0xffff0000u), __uint_as_float(b << 16), __uint_as_float(b & 0xffff0000u)}; }
template <int MODE, bool RLO, bool WLO> struct EpiResid {
    static constexpr bool PERM = true, AFTER_DRAIN = false;
    const float* basef; const bf16_t* bhi; const bf16_t* lo; bf16_t* olo; bf16_t* ohi; float* ssq; float scale;
    __device__ __forceinline__ void operator()(const f32x4 (&acc)[2][2][4][2], const Unit& u, int wr, int wc, int fr, int fq) const {
        const int row0 = u.pm * 256 + wr * 64 + fr, col0 = u.pn * 256 + wc * 32 + 8 * fq;
#pragma unroll
        for (int ai = 0; ai < 2; ++ai)
#pragma unroll
            for (int m = 0; m < 4; ++m) {
                const int row = row0 + ai * 128 + m * 16; float ss = 0.f;
#pragma unroll
                for (int bj = 0; bj < 2; ++bj) {
                    const size_t off = (size_t)row * D_ + col0 + bj * 128;
                    f32x4 b0, b1;
                    if (MODE == 0) { b0 = *(const f32x4*)(basef + off); b1 = *(const f32x4*)(basef + off + 4); }
                    else { const u32x4 h = *(const u32x4*)(bhi + off); b0 = bflo4(h.x, h.y); b1 = bflo4(h.z, h.w);
                           if (RLO) { const u32x4 l = *(const u32x4*)(lo + off); b0 = b0 + bflo4(l.x, l.y); b1 = b1 + bflo4(l.z, l.w); } }
                    const f32x4 v0 = b0 + acc[ai][bj][m][0] * scale, v1 = b1 + acc[ai][bj][m][1] * scale;
                    u32x4 w; w.x = pk2(v0[0], v0[1]); w.y = pk2(v0[2], v0[3]); w.z = pk2(v1[0], v1[1]); w.w = pk2(v1[2], v1[3]);
                    const f32x4 r0 = v0 - bflo4(w.x, w.y), r1 = v1 - bflo4(w.z, w.w);
                    u32x4 wl; wl.x = pk2(r0[0], r0[1]); wl.y = pk2(r0[2], r0[3]); wl.z = pk2(r1[0], r1[1]); wl.w = pk2(r1[2], r1[3]);
                    *(u32x4*)(ohi + off) = w; if (WLO) *(u32x4*)(olo + off) = wl;
                    ss += ((v0[0] * v0[0] + v0[1] * v0[1]) + (v0[2] * v0[2] + v0[3] * v0[3])) + ((v1[0] * v1[0] + v1[1] * v1[1]) + (v1[2] * v1[2] + v1[3] * v1[3]));
                }
                ss += __shfl_xor(ss, 16); ss += __shfl_xor(ss, 32);
                if (fq == 0) ssq[(size_t)row * 16 + u.pn * 4 + wc] = ss;
            }
    }
};
struct EpiZ {
    static constexpr bool PERM = true, AFTER_DRAIN = false;
    bf16_t* zr; bf16_t* zg; const float* ssq; float* lnst;
    __device__ __forceinline__ void operator()(const f32x4 (&acc)[2][2][4][2], const Unit& u, int wr, int wc, int fr, int fq) const {
        const int row0 = u.pm * 256 + wr * 64 + fr; const bool isg = u.pn >= 7;
        const int col0 = (isg ? (u.pn - 7) * 256 : u.pn * 256) + wc * 32 + 8 * fq;
        bf16_t* basep = isg ? zg : zr; const int ld = isg ? 1024 : RC_;
#pragma unroll
        for (int ai = 0; ai < 2; ++ai)
#pragma unroll
            for (int m = 0; m < 4; ++m) {
                const int row = row0 + ai * 128 + m * 16; const float rs = row_rstd_q(ssq, row, fq); float s1 = 0.f, s2 = 0.f;
#pragma unroll
                for (int bj = 0; bj < 2; ++bj) {
                    f32x4 v0 = acc[ai][bj][m][0] * rs, v1 = acc[ai][bj][m][1] * rs;
                    if (isg) {
#pragma unroll
                        for (int j = 0; j < 4; ++j) { v0[j] = gelu_erf(v0[j]); v1[j] = gelu_erf(v1[j]); }
                        s1 += ((v0[0] + v0[1]) + (v0[2] + v0[3])) + ((v1[0] + v1[1]) + (v1[2] + v1[3]));
                        s2 += ((v0[0] * v0[0] + v0[1] * v0[1]) + (v0[2] * v0[2] + v0[3] * v0[3])) + ((v1[0] * v1[0] + v1[1] * v1[1]) + (v1[2] * v1[2] + v1[3] * v1[3]));
                    }
                    u32x4 w; w.x = pk2(v0[0], v0[1]); w.y = pk2(v0[2], v0[3]); w.z = pk2(v1[0], v1[1]); w.w = pk2(v1[2], v1[3]);
                    *(u32x4*)(basep + (size_t)row * ld + col0 + bj * 128) = w;
                }
                if (u.pn >= 9) {
                    s1 += __shfl_xor(s1, 16); s1 += __shfl_xor(s1, 32); s2 += __shfl_xor(s2, 16); s2 += __shfl_xor(s2, 32);
                    if (fq == 0) { f32x2 o; o.x = s1; o.y = s2; *(f32x2*)(lnst + (size_t)row * 16 + ((u.pn - 9) * 4 + wc) * 2) = o; }
                }
            }
    }
};
struct EpiPE {
    static constexpr bool PERM = true, AFTER_DRAIN = false;
    bf16_t* pe;
    __device__ __forceinline__ void operator()(const f32x4 (&acc)[2][2][4][2], const Unit& u, int wr, int wc, int fr, int fq) const {
        const int row0 = u.pm * 256 + wr * 64 + fr, col0 = u.pn * 256 + wc * 32 + 8 * fq;
#pragma unroll
        for (int ai = 0; ai < 2; ++ai)
#pragma unroll
            for (int m = 0; m < 4; ++m)
#pragma unroll
                for (int bj = 0; bj < 2; ++bj) {
                    const size_t off = (size_t)(row0 + ai * 128 + m * 16) * D_ + col0 + bj * 128;
                    const f32x4 v0 = acc[ai][bj][m][0], v1 = acc[ai][bj][m][1];
                    u32x4 w; w.x = pk2(v0[0], v0[1]); w.y = pk2(v0[2], v0[3]); w.z = pk2(v1[0], v1[1]); w.w = pk2(v1[2], v1[3]);
                    *(u32x4*)(pe + off) = w;
                }
    }
};
struct EpiGate {
    static constexpr bool PERM = true, AFTER_DRAIN = false;
    const bf16_t* pe; const bf16_t* h3hi; const bf16_t* h3lo; bf16_t* h4; const float* ssq_in; float* ssq;
    __device__ __forceinline__ void operator()(const f32x4 (&acc)[2][2][4][2], const Unit& u, int wr, int wc, int fr, int fq) const {
        const int row0 = u.pm * 256 + wr * 64 + fr, col0 = u.pn * 256 + wc * 32 + 8 * fq;
#pragma unroll
        for (int ai = 0; ai < 2; ++ai)
#pragma unroll
            for (int m = 0; m < 4; ++m) {
                const int row = row0 + ai * 128 + m * 16; const float rs = row_rstd_q(ssq_in, row, fq); float ss = 0.f;
#pragma unroll
                for (int bj = 0; bj < 2; ++bj) {
                    const size_t off = (size_t)row * D_ + col0 + bj * 128;
                    const u32x4 hh = *(const u32x4*)(h3hi + off);
                    f32x4 b0 = bflo4(hh.x, hh.y), b1 = bflo4(hh.z, hh.w);
                    if (h3lo) { const u32x4 hl = *(const u32x4*)(h3lo + off); b0 = b0 + bflo4(hl.x, hl.y); b1 = b1 + bflo4(hl.z, hl.w); }
                    const u32x4 pw = *(const u32x4*)(pe + off);
                    const f32x4 p0 = (f32x4){__uint_as_float(pw.x << 16), __uint_as_float(pw.x & 0xffff0000u), __uint_as_float(pw.y << 16), __uint_as_float(pw.y & 0xffff0000u)};
                    const f32x4 p1 = (f32x4){__uint_as_float(pw.z << 16), __uint_as_float(pw.z & 0xffff0000u), __uint_as_float(pw.w << 16), __uint_as_float(pw.w & 0xffff0000u)};
                    f32x4 v0, v1;
#pragma unroll
                    for (int j = 0; j < 4; ++j) { v0[j] = b0[j] + sigmoidf_(acc[ai][bj][m][0][j] * rs) * p0[j]; v1[j] = b1[j] + sigmoidf_(acc[ai][bj][m][1][j] * rs) * p1[j]; }
                    u32x4 w; w.x = pk2(v0[0], v0[1]); w.y = pk2(v0[2], v0[3]); w.z = pk2(v1[0], v1[1]); w.w = pk2(v1[2], v1[3]);
                    *(u32x4*)(h4 + off) = w;
                    ss += ((v0[0] * v0[0] + v0[1] * v0[1]) + (v0[2] * v0[2] + v0[3] * v0[3])) + ((v1[0] * v1[0] + v1[1] * v1[1]) + (v1[2] * v1[2] + v1[3] * v1[3]));
                }
                ss += __shfl_xor(ss, 16); ss += __shfl_xor(ss, 32);
                if (fq == 0) ssq[(size_t)row * 16 + u.pn * 4 + wc] = ss;
            }
    }
};

struct EpiGateFinal {
    static constexpr bool PERM = true, AFTER_DRAIN = true;
    const bf16_t* pe; const bf16_t* h3hi; const bf16_t* h3lo  ; float* out; const float* gfin; const float* ssq_in; float* ssq; unsigned* cnt;
    __device__ __forceinline__ void operator()(const f32x4 (&)[2][2][4][2], const Unit&, int, int, int, int) const {}
    __device__ __forceinline__ void fused(const f32x4 (&acc_)[2][2][4][2], const Unit& u, int wr, int wc, int fr, int fq, LAS unsigned char*, int, int) const {
        f32x4 (&acc)[2][2][4][2] = const_cast<f32x4 (&)[2][2][4][2]>(acc_);
        const int row0 = u.pm * 256 + wr * 64 + fr, col0 = u.pn * 256 + wc * 32 + 8 * fq;
#pragma unroll
        for (int ai = 0; ai < 2; ++ai)
#pragma unroll
            for (int m = 0; m < 4; ++m) {
                const int row = row0 + ai * 128 + m * 16; const float rs = row_rstd_q(ssq_in, row, fq); float ss = 0.f;
#pragma unroll
                for (int bj = 0; bj < 2; ++bj) {
                    const size_t off = (size_t)row * D_ + col0 + bj * 128;
                    const u32x4 hh = *(const u32x4*)(h3hi + off);
                    f32x4 b0 = bflo4(hh.x, hh.y), b1 = bflo4(hh.z, hh.w);
                    if (h3lo) { const u32x4 hl = *(const u32x4*)(h3lo + off); b0 = b0 + bflo4(hl.x, hl.y); b1 = b1 + bflo4(hl.z, hl.w); }
                    const u32x4 pw = *(const u32x4*)(pe + off);
                    const f32x4 p0 = bflo4(pw.x, pw.y), p1 = bflo4(pw.z, pw.w);
                    f32x4 v0, v1;
#pragma unroll
                    for (int j = 0; j < 4; ++j) { v0[j] = b0[j] + sigmoidf_(acc[ai][bj][m][0][j] * rs) * p0[j]; v1[j] = b1[j] + sigmoidf_(acc[ai][bj][m][1][j] * rs) * p1[j]; }
                    acc[ai][bj][m][0] = v0; acc[ai][bj][m][1] = v1;
                    ss += ((v0[0] * v0[0] + v0[1] * v0[1]) + (v0[2] * v0[2] + v0[3] * v0[3])) + ((v1[0] * v1[0] + v1[1] * v1[1]) + (v1[2] * v1[2] + v1[3] * v1[3]));
                }
                ss += __shfl_xor(ss, 16); ss += __shfl_xor(ss, 32);
                if (fq == 0) ssq[(size_t)row * 16 + u.pn * 4 + wc] = ss;
            }
        asm volatile("s_waitcnt vmcnt(0)" ::: "memory");
        __syncthreads();
        if (threadIdx.x == 0) {
            __builtin_amdgcn_fence(__ATOMIC_RELEASE, "agent");
            asm volatile("s_waitcnt vmcnt(0)" ::: "memory");
            unsigned* c = cnt + 64 * u.pm;
            (void)__hip_atomic_fetch_add(c, 1u, __ATOMIC_RELAXED, __HIP_MEMORY_SCOPE_AGENT);
            unsigned sp = 0;
            while (__hip_atomic_load(c, __ATOMIC_RELAXED, __HIP_MEMORY_SCOPE_AGENT) < 4u) { __builtin_amdgcn_s_sleep(1); if (++sp > (1u << 22)) break; }
            __builtin_amdgcn_fence(__ATOMIC_ACQUIRE, "agent");
            asm volatile("s_waitcnt vmcnt(0)" ::: "memory");
        }
        __syncthreads();
        f32x4 g0[2], g1[2];
#pragma unroll
        for (int bj = 0; bj < 2; ++bj) { g0[bj] = *(const f32x4*)(gfin + col0 + bj * 128); g1[bj] = *(const f32x4*)(gfin + col0 + bj * 128 + 4); }
#pragma unroll
        for (int ai = 0; ai < 2; ++ai)
#pragma unroll
            for (int m = 0; m < 4; ++m) {
                const int row = row0 + ai * 128 + m * 16; const float rs = row_rstd_q(ssq, row, fq);
#pragma unroll
                for (int bj = 0; bj < 2; ++bj) {
                    const size_t off = (size_t)row * D_ + col0 + bj * 128;
                    *(f32x4*)(out + off) = acc[ai][bj][m][0] * rs * g0[bj]; *(f32x4*)(out + off + 4) = acc[ai][bj][m][1] * rs * g1[bj];
                }
            }
    }
};

__device__ __forceinline__ int map13(int hidden, int which) { return (hidden >> 7) * 256 + which * 128 + (hidden & 127); }
__device__ __forceinline__ void transpose_item(const float* W, int K, int N, const float* gain, bf16_t* WT, int mode, LAS float* scr, int item, int lane) {
    const int nblk = N / 32, kb = item / nblk, nb = item % nblk, k0 = 64 * kb, n0 = 32 * nb;
#pragma unroll
    for (int i = 0; i < 32; ++i) { const int kk = 2 * i + (lane >> 5); float w = W[(size_t)(k0 + kk) * N + n0 + (lane & 31)]; if (gain) w *= gain[k0 + kk]; scr[kk * 33 + (lane & 31)] = w; }
    asm volatile("s_waitcnt lgkmcnt(0)" ::: "memory");
    const int c = lane & 7;
#pragma unroll
    for (int j = 0; j < 4; ++j) { const int n = (lane >> 3) + 8 * j; const LAS float* s = scr + (8 * c) * 33 + n;
        u32x4 o; o.x = pk2(s[0 * 33], s[1 * 33]); o.y = pk2(s[2 * 33], s[3 * 33]); o.z = pk2(s[4 * 33], s[5 * 33]); o.w = pk2(s[6 * 33], s[7 * 33]);
        const int row = (mode == 0) ? (n0 + n) : map13(n0 + n, mode - 1);
        *(u32x4*)(WT + (size_t)row * K + k0 + 8 * c) = o; }
    asm volatile("s_waitcnt lgkmcnt(0)" ::: "memory");
}

template <class FA, class FB>
__device__ __forceinline__ void mm_acc(f32x4 (&acc)[2], int K, int mrow, int nc0, int q, FA fa, FB fb) {
#pragma unroll 4
    for (int k0 = 0; k0 < K; k0 += 4) {
        const float a = fa(mrow, k0 + q), b0 = fb(k0 + q, nc0), b1 = fb(k0 + q, nc0 + 16);
        acc[0] = __builtin_amdgcn_mfma_f32_16x16x4f32(a, b0, acc[0], 0, 0, 0);
        acc[1] = __builtin_amdgcn_mfma_f32_16x16x4f32(a, b1, acc[1], 0, 0, 0);
    }
}
#define ZACC(a) do { a[0] = (f32x4){0.f, 0.f, 0.f, 0.f}; a[1] = (f32x4){0.f, 0.f, 0.f, 0.f}; } while (0)

struct Ctx {
    LAS unsigned char* lds; int tid, lane, wave, G, bid;
    const float* const* in; float* out; unsigned char* ws;
};
#define MAT(i) ((LAS float*)(C.lds + (i) * MBYTES))

__device__ __forceinline__ float zshift(const bf16_t* zr, int tok, int col, float mu) {
    const float cur = bf2f(zr[(size_t)tok * RC_ + col]);
    const float prv = bf2f(zr[(size_t)(tok > 0 ? tok - 1 : 0) * RC_ + col]) * (tok > 0 ? 1.f : 0.f);
    return cur + (prv - cur) * mu;
}

constexpr int BS = 72;
constexpr int BBYTES = 64 * BS * 2;
constexpr int F_OFF = 0, B_OFF = 3 * MBYTES;
constexpr int AMISC_OFF = B_OFF + 11 * BBYTES;
constexpr size_t WS_LORA = 254 * MiB;
#define FM(i) ((LAS float*)(C.lds + F_OFF + (i) * MBYTES))
#define BM_(i) ((LAS bf16_t*)(C.lds + B_OFF + (i) * BBYTES))
__device__ __forceinline__ void mmb(f32x4 (&acc)[2], const LAS bf16_t* A, const LAS bf16_t* B, int mrow, int nc0, int q) {
#pragma unroll
    for (int ks = 0; ks < 2; ++ks) {
        const bf16x8 a = *(const LAS bf16x8*)(A + mrow * BS + ks * 32 + q * 8);
        const bf16x8 b0 = *(const LAS bf16x8*)(B + nc0 * BS + ks * 32 + q * 8), b1 = *(const LAS bf16x8*)(B + (nc0 + 16) * BS + ks * 32 + q * 8);
        acc[0] = __builtin_amdgcn_mfma_f32_16x16x32_bf16(a, b0, acc[0], 0, 0, 0);
        acc[1] = __builtin_amdgcn_mfma_f32_16x16x32_bf16(a, b1, acc[1], 0, 0, 0);
    }
}
__device__ __forceinline__ void mmb_g(f32x4 (&acc)[2], const LAS bf16_t* A, const bf16_t* Bg, int ldb, int mrow, int nrow0, int q) {
#pragma unroll
    for (int ks = 0; ks < 2; ++ks) {
        const bf16x8 a = *(const LAS bf16x8*)(A + mrow * BS + ks * 32 + q * 8);
        const bf16x8 b0 = *(const bf16x8*)(Bg + (size_t)nrow0 * ldb + ks * 32 + q * 8), b1 = *(const bf16x8*)(Bg + (size_t)(nrow0 + 16) * ldb + ks * 32 + q * 8);
        acc[0] = __builtin_amdgcn_mfma_f32_16x16x32_bf16(a, b0, acc[0], 0, 0, 0);
        acc[1] = __builtin_amdgcn_mfma_f32_16x16x32_bf16(a, b1, acc[1], 0, 0, 0);
    }
}
__device__ __forceinline__ void mmb_gg(f32x4 (&acc)[2], const bf16_t* Ag, int lda, const bf16_t* Bg, int ldb, int mrow, int nrow0, int q) {
#pragma unroll
    for (int ks = 0; ks < 2; ++ks) {
        const bf16x8 a = *(const bf16x8*)(Ag + (size_t)mrow * lda + ks * 32 + q * 8);
        const bf16x8 b0 = *(const bf16x8*)(Bg + (size_t)nrow0 * ldb + ks * 32 + q * 8), b1 = *(const bf16x8*)(Bg + (size_t)(nrow0 + 16) * ldb + ks * 32 + q * 8);
        acc[0] = __builtin_amdgcn_mfma_f32_16x16x32_bf16(a, b0, acc[0], 0, 0, 0);
        acc[1] = __builtin_amdgcn_mfma_f32_16x16x32_bf16(a, b1, acc[1], 0, 0, 0);
    }
}
__device__ __forceinline__ void zload9(const bf16_t* zr, int tok, int col, bf16_t (&raw)[9]) {
    raw[0] = zr[(size_t)(tok > 0 ? tok - 1 : 0) * RC_ + col];
#pragma unroll
    for (int u = 0; u < 8; ++u) raw[u + 1] = zr[(size_t)(tok + u) * RC_ + col];
}
__device__ __forceinline__ void zmix8(const bf16_t (&raw)[9], float pz, float mu, float (&o)[8]) {
    float prv = bf2f(raw[0]) * pz;
#pragma unroll
    for (int u = 0; u < 8; ++u) { const float cur = bf2f(raw[u + 1]); o[u] = cur + (prv - cur) * mu; prv = cur; }
}
__device__ __forceinline__ u32x4 pack8(const float (&v)[8]) { u32x4 w; w.x = pk2(v[0], v[1]); w.y = pk2(v[2], v[3]); w.z = pk2(v[4], v[5]); w.w = pk2(v[6], v[7]); return w; }

__device__ __forceinline__ void rwkv_phase_a(const Ctx& C) {
    const bf16_t* zr = (const bf16_t*)(C.ws + WS_ZR);
    const float* mu = C.in[8]; const float* w0 = C.in[9]; const float* a0 = C.in[11];
    const float* k_k = C.in[14]; const float* k_a = C.in[15]; const float* r_k = C.in[16];
    const bf16_t* wdecT = (const bf16_t*)(C.ws + WS_LORA); const bf16_t* waaaT = wdecT + 512 * 64; const bf16_t* wgateT = waaaT + 512 * 64;
    float* Pg = (float*)(C.ws + WS_P); float* Qg = (float*)(C.ws + WS_Q); bf16_t* Y0g = (bf16_t*)(C.ws + WS_Y0); bf16_t* Rcg = (bf16_t*)(C.ws + WS_RC);
    bf16_t* Gg = (bf16_t*)(C.ws + WS_G); float* bon = (float*)(C.ws + WS_BON);
    LAS float* misc = (LAS float*)(C.lds + AMISC_OFF);
    LAS float* DI = (LAS float*)BM_(10);
    const int w = C.wave;
    const int mt = w >> 1, nt0 = (w & 1) * 2;

    bf16_t* scrg = (bf16_t*)(C.ws + WS_PC) + (size_t)C.bid * (64 * 256);
    for (int c = C.bid; c < NCH; c += C.G) {
      const int tok0 = c * 64;
      {
          int tid = C.tid; asm volatile("" : "+v"(tid));
          const int ci = tid & 63, tg8 = tid >> 6, tokb = tok0 + tg8 * 8;
          bf16_t r0[9], r1[9], r2[9], r3[9];
          zload9(zr, tokb, 1536 + ci, r0); zload9(zr, tokb, 1600 + ci, r1); zload9(zr, tokb, 1664 + ci, r2); zload9(zr, tokb, 1728 + ci, r3);
          const float m0 = mu[1536 + ci], m1 = mu[1600 + ci], m2 = mu[1664 + ci], m3 = mu[1728 + ci];
          const float pz = tokb > 0 ? 1.f : 0.f;
          float t8[8];
          zmix8(r0, pz, m0, t8);
#pragma unroll
          for (int u = 0; u < 8; ++u) scrg[(tg8 * 8 + u) * 256 + ci] = f2bf(tanhf_(t8[u]));
          zmix8(r1, pz, m1, t8);
#pragma unroll
          for (int u = 0; u < 8; ++u) scrg[(tg8 * 8 + u) * 256 + 64 + ci] = f2bf(t8[u]);
          zmix8(r2, pz, m2, t8);
#pragma unroll
          for (int u = 0; u < 8; ++u) scrg[(tg8 * 8 + u) * 256 + 128 + ci] = f2bf(sigmoidf_(t8[u]));
          zmix8(r3, pz, m3, t8);
#pragma unroll
          for (int u = 0; u < 8; ++u) scrg[(tg8 * 8 + u) * 256 + 192 + ci] = f2bf(sigmoidf_(t8[u]));
          asm volatile("s_waitcnt vmcnt(0)" ::: "memory");
          __syncthreads();
          __builtin_amdgcn_fence(__ATOMIC_ACQUIRE, "agent");
          asm volatile("s_waitcnt vmcnt(0)" ::: "memory");
      }
      bf16x8 Af[4][2], Bf[4][2][2]; bf16_t zn[3][9];
      {
          int tid = C.tid; asm volatile("" : "+v"(tid));
          const int lane = tid & 63, q = lane >> 4, l15 = lane & 15, mrow = mt * 16 + l15, nc0 = nt0 * 16 + l15, ci = tid & 63, tokb = tok0 + (tid >> 6) * 8;
#pragma unroll
          for (int g = 0; g < 4; ++g)
#pragma unroll
              for (int ks = 0; ks < 2; ++ks) Af[g][ks] = *(const bf16x8*)(scrg + (size_t)mrow * 256 + g * 64 + ks * 32 + q * 8);
#pragma unroll
          for (int ks = 0; ks < 2; ++ks)
#pragma unroll
              for (int i = 0; i < 2; ++i) { const int row = nc0 + 16 * i;
                  Bf[0][ks][i] = *(const bf16x8*)(wdecT + (size_t)row * 64 + ks * 32 + q * 8); Bf[1][ks][i] = *(const bf16x8*)(waaaT + (size_t)row * 64 + ks * 32 + q * 8);
                  Bf[2][ks][i] = *(const bf16x8*)(wgateT + (size_t)row * 128 + ks * 32 + q * 8); Bf[3][ks][i] = *(const bf16x8*)(wgateT + (size_t)row * 128 + 64 + ks * 32 + q * 8); }
          zload9(zr, tokb, ci, zn[0]); zload9(zr, tokb, 512 + ci, zn[1]); zload9(zr, tokb, 1024 + ci, zn[2]);
      }
      for (int h = 0; h < 8; ++h) {
        const int item = c * 8 + h;
        int tid = C.tid; asm volatile("" : "+v"(tid));
        const int lane = tid & 63, q = lane >> 4, l15 = lane & 15;
        const int mrow = mt * 16 + l15, nc0 = nt0 * 16 + l15;
        const int ci = tid & 63, tg8 = tid >> 6;
        const int tokb = tok0 + tg8 * 8;
        float rr[8], kx[8], vx[8];
        {
            const float m4 = mu[h * 64 + ci], m5 = mu[512 + h * 64 + ci], m6 = mu[1024 + h * 64 + ci];
            const float pz = tokb > 0 ? 1.f : 0.f;
            zmix8(zn[0], pz, m4, rr); zmix8(zn[1], pz, m5, kx); zmix8(zn[2], pz, m6, vx);
        }
        {
            f32x4 aw[2], aa[2], ag[2]; ZACC(aw); ZACC(aa); ZACC(ag);
#pragma unroll
            for (int ks = 0; ks < 2; ++ks)
#pragma unroll
                for (int i = 0; i < 2; ++i) {
                    aw[i] = __builtin_amdgcn_mfma_f32_16x16x32_bf16(Af[0][ks], Bf[0][ks][i], aw[i], 0, 0, 0);
                    aa[i] = __builtin_amdgcn_mfma_f32_16x16x32_bf16(Af[1][ks], Bf[1][ks][i], aa[i], 0, 0, 0);
                    ag[i] = __builtin_amdgcn_mfma_f32_16x16x32_bf16(Af[2][ks], Bf[2][ks][i], ag[i], 0, 0, 0);
                    ag[i] = __builtin_amdgcn_mfma_f32_16x16x32_bf16(Af[3][ks], Bf[3][ks][i], ag[i], 0, 0, 0);
                }
            if (h + 1 < 8) {
                const int hn = h + 1;
#pragma unroll
                for (int ks = 0; ks < 2; ++ks)
#pragma unroll
                    for (int i = 0; i < 2; ++i) { const int row = hn * 64 + nc0 + 16 * i;
                        Bf[0][ks][i] = *(const bf16x8*)(wdecT + (size_t)row * 64 + ks * 32 + q * 8); Bf[1][ks][i] = *(const bf16x8*)(waaaT + (size_t)row * 64 + ks * 32 + q * 8);
                        Bf[2][ks][i] = *(const bf16x8*)(wgateT + (size_t)row * 128 + ks * 32 + q * 8); Bf[3][ks][i] = *(const bf16x8*)(wgateT + (size_t)row * 128 + 64 + ks * 32 + q * 8); }
                zload9(zr, tokb, hn * 64 + ci, zn[0]); zload9(zr, tokb, 512 + hn * 64 + ci, zn[1]); zload9(zr, tokb, 1024 + hn * 64 + ci, zn[2]);
            }
#pragma unroll
            for (int i = 0; i < 2; ++i) {
                const int ch = nc0 + 16 * i; const float w0c = w0[h * 64 + ch], a0c = a0[h * 64 + ch];
#pragma unroll
                for (int j = 0; j < 4; ++j) {
                    const int t = mt * 16 + 4 * q + j;
                    FM(0)[t * MS + ch] = -0.60653065971f * sigmoidf_(w0c + aw[i][j]);
                    FM(1)[t * MS + ch] = sigmoidf_(a0c + aa[i][j]);
                    Gg[(size_t)(tok0 + t) * GWD_ + h * 64 + ch] = f2bf(ag[i][j]);
                }
            }
        }
        __syncthreads();
        {
            float ld[8], av[8], kkv[8], k2[8], cl[8];
            const float kkc = k_k[h * 64 + ci], kac = k_a[h * 64 + ci], rkc = r_k[h * 64 + ci];
            float run = 0.f;
#pragma unroll
            for (int u = 0; u < 8; ++u) {
                const int t = tg8 * 8 + u;
                ld[u] = FM(0)[t * MS + ci]; av[u] = FM(1)[t * MS + ci];
                const float kr = kx[u] * kkc; const float n2 = wave_sum(kr * kr);
                kkv[u] = kr * __builtin_amdgcn_rsqf(fmaxf(n2, 1e-24f));
                k2[u] = kx[u] * (1.0f + (av[u] - 1.0f) * kac);
                const float bs = wave_sum(rr[u] * k2[u] * rkc);
                if (lane == 0) bon[(size_t)(tok0 + t) * 8 + h] = bs;
                run += ld[u]; cl[u] = run;
            }
            misc[64 + tg8 * 64 + ci] = run;
            __syncthreads();
            float pre = 0.f, tot = 0.f;
#pragma unroll
            for (int g = 0; g < 8; ++g) { const float v = misc[64 + g * 64 + ci]; tot += v; if (g < tg8) pre += v; }
            if (tg8 == 0) misc[ci] = __expf(tot);
            float bh[8], kh[8];
#pragma unroll
            for (int u = 0; u < 8; ++u) {
                const int t = tg8 * 8 + u; const float cu = cl[u] + pre, cp = cu - ld[u];
                const float e_m = __expf(-cu), e_p = __expf(cu), e_t = __expf(tot - cu);
                const float at = kkv[u] * __expf(cp);
                BM_(0)[t * BS + ci] = f2bf(at); FM(2)[t * MS + ci] = at;
                BM_(1)[t * BS + ci] = f2bf(kkv[u] * av[u] * e_m);
                BM_(2)[t * BS + ci] = f2bf(k2[u] * e_m);
                BM_(3)[t * BS + ci] = f2bf(rr[u] * e_p);
                bh[u] = kkv[u] * av[u] * e_t; kh[u] = k2[u] * e_t;
            }
            *(LAS u32x4*)(BM_(4) + ci * BS + tg8 * 8) = pack8(vx);
            *(LAS u32x4*)(BM_(5) + ci * BS + tg8 * 8) = pack8(bh);
            *(LAS u32x4*)(BM_(6) + ci * BS + tg8 * 8) = pack8(kh);
        }
        __syncthreads();
        {
            f32x4 x1[2], x2[2], x3[2], x4[2]; ZACC(x1); ZACC(x2); ZACC(x3); ZACC(x4);
            mmb(x1, BM_(0), BM_(2), mrow, nc0, q);
            mmb(x2, BM_(0), BM_(1), mrow, nc0, q);
            mmb(x3, BM_(3), BM_(1), mrow, nc0, q);
            mmb(x4, BM_(3), BM_(2), mrow, nc0, q);
#pragma unroll
            for (int i = 0; i < 2; ++i)
#pragma unroll
                for (int j = 0; j < 4; ++j) { const int r = mt * 16 + 4 * q + j, cc = nc0 + 16 * i;
                    BM_(7)[r * BS + cc] = f2bf(r > cc ? x1[i][j] : 0.f); FM(0)[r * MS + cc] = r > cc ? x2[i][j] : 0.f;
                    BM_(8)[r * BS + cc] = f2bf(r >= cc ? x3[i][j] : 0.f); BM_(9)[r * BS + cc] = f2bf(r >= cc ? x4[i][j] : 0.f); }
        }
        __syncthreads();
        {
            f32x4 x1[2]; ZACC(x1);
            mmb(x1, BM_(7), BM_(4), mrow, nc0, q);
#pragma unroll
            for (int i = 0; i < 2; ++i)
#pragma unroll
                for (int j = 0; j < 4; ++j) { const int r = mt * 16 + 4 * q + j, cc = nc0 + 16 * i; FM(1)[r * MS + cc] = x1[i][j]; }
            if (tid < 64) {
                const int blk = tid >> 4, col = tid & 15; const LAS float* L = FM(0) + (blk * 16) * MS + blk * 16;
                float x[16];
#pragma unroll
                for (int r = 0; r < 16; ++r) {
                    float a = (r == col) ? 1.f : 0.f;
#pragma unroll
                    for (int s2 = 0; s2 < r; ++s2) a -= L[r * MS + s2] * x[s2];
                    x[r] = a;
                }
#pragma unroll
                for (int r = 0; r < 16; ++r) DI[(blk * 16 + r) * 20 + col] = x[r];
            }
        }
        __syncthreads();
        {
            LAS float* RH = (w < 4) ? FM(2) : FM(1); const int cb = (w & 3) * 16;
            const LAS float* L = FM(0);
#pragma unroll
            for (int bi = 0; bi < 4; ++bi) {
                f32x4 t4;
#pragma unroll
                for (int j = 0; j < 4; ++j) t4[j] = RH[(bi * 16 + 4 * q + j) * MS + cb + l15];
#pragma unroll
                for (int bj = 0; bj < bi; ++bj)
#pragma unroll
                    for (int kk = 0; kk < 4; ++kk) {
                        const float a = -L[(bi * 16 + l15) * MS + bj * 16 + 4 * kk + q];
                        const float b = RH[(bj * 16 + 4 * kk + q) * MS + cb + l15];
                        t4 = __builtin_amdgcn_mfma_f32_16x16x4f32(a, b, t4, 0, 0, 0);
                    }
                const f32x4 dv = *(const LAS f32x4*)(DI + (bi * 16 + l15) * 20 + 4 * q);
                f32x4 o4 = (f32x4){0.f, 0.f, 0.f, 0.f};
#pragma unroll
                for (int j = 0; j < 4; ++j) o4 = __builtin_amdgcn_mfma_f32_16x16x4f32(dv[j], t4[j], o4, 0, 0, 0);
#pragma unroll
                for (int j = 0; j < 4; ++j) RH[(bi * 16 + 4 * q + j) * MS + cb + l15] = o4[j];
            }
            LAS bf16_t* WT = (w < 4) ? BM_(0) : BM_(1);
            float v8[8];
#pragma unroll
            for (int hh = 0; hh < 2; ++hh) {
#pragma unroll
                for (int i = 0; i < 8; ++i) v8[i] = RH[(q * 16 + hh * 8 + i) * MS + cb + l15];
                *(LAS u32x4*)(WT + (cb + l15) * BS + q * 16 + hh * 8) = pack8(v8);
            }
        }
        __syncthreads();
        {
            f32x4 xp[2], xa[2], xb[2]; ZACC(xp); ZACC(xa); ZACC(xb);
            mmb(xp, BM_(0), BM_(5), mrow, nc0, q);
            mmb(xa, BM_(1), BM_(5), mrow, nc0, q);
            mmb(xb, BM_(4), BM_(6), mrow, nc0, q);
            float* Pi = Pg + (size_t)item * 4096; float* Qi = Qg + (size_t)item * 4096;
#pragma unroll
            for (int i = 0; i < 2; ++i)
#pragma unroll
                for (int j = 0; j < 4; ++j) { const int r = mt * 16 + 4 * q + j, cc = nc0 + 16 * i;
                    Pi[r * 64 + cc] = (r == cc ? misc[r] : 0.f) - xp[i][j]; Qi[r * 64 + cc] = xb[i][j] - xa[i][j]; }
            f32x4 xr[2], ya[2], yb[2]; ZACC(xr); ZACC(ya); ZACC(yb);
            mmb(xr, BM_(8), BM_(0), mrow, nc0, q);
            mmb(ya, BM_(8), BM_(1), mrow, nc0, q);
            mmb(yb, BM_(9), BM_(4), mrow, nc0, q);
            bf16_t* Ri = Rcg + (size_t)item * 4096; bf16_t* Yi = Y0g + (size_t)item * 4096;
#pragma unroll
            for (int i = 0; i < 2; ++i)
#pragma unroll
                for (int j = 0; j < 4; ++j) { const int r = mt * 16 + 4 * q + j, cc = nc0 + 16 * i;
                    Ri[r * 64 + cc] = f2bf(bf2f(BM_(3)[r * BS + cc]) - xr[i][j]); Yi[r * 64 + cc] = f2bf(yb[i][j] - ya[i][j]); }
        }
        __syncthreads();
      }
    }
}

__device__ __forceinline__ void gmlp_phase(const Ctx& C) {
    const bf16_t* zg = (const bf16_t*)(C.ws + WS_ZG); const float* lnst = (const float*)(C.ws + WS_LNST);
    const float* ln_g = C.in[19]; const float* ln_b = C.in[20]; const float* w_s = C.in[21]; const float* b_s = C.in[22];
    bf16_t* ycat = (bf16_t*)(C.ws + WS_ACTA);
    constexpr int AS = 136;
    LAS bf16_t* Aw = (LAS bf16_t*)C.lds;
    LAS bf16_t* vT = (LAS bf16_t*)(C.lds + 128 * AS * 2);
    LAS float* st = (LAS float*)(C.lds + 192 * AS * 2);
    const int tid = C.tid, lane = C.lane, w = C.wave, q = lane >> 4, l15 = lane & 15;
    const int nslots = (C.G >= 8) ? (C.G / 8) : 1;
    const int h = C.bid & 7, slot = C.bid >> 3;
    if (C.G >= 8 && slot >= nslots) return;
    for (int hh = (C.G >= 8 ? h : 0); hh < (C.G >= 8 ? h + 1 : 8); ++hh) {
        __syncthreads();
        for (int e = tid; e < 128 * 64; e += NTHR) {
            const int t = e >> 6, s2 = (e & 63) * 2;
            const f32x2 wv = *(const f32x2*)(w_s + ((size_t)hh * 128 + t) * 128 + s2);
            const unsigned pk = pk2(s2 <= t ? wv.x : 0.f, (s2 + 1) <= t ? wv.y : 0.f);
            *(LAS unsigned*)(Aw + t * AS + s2) = pk;
        }
        for (int ch = (C.G >= 8 ? slot : C.bid); ch < 128; ch += (C.G >= 8 ? nslots : C.G)) {
            const int tok0 = ch * 128;
            const int dd = tid & 63;
            bf16_t vr[16], ur[4][4]; float bsr[4]; f32x4 sta = (f32x4){0.f, 0.f, 0.f, 0.f}, stb = sta, stc = sta, std_ = sta;
#pragma unroll
            for (int i = 0; i < 16; ++i) vr[i] = zg[(size_t)(tok0 + (tid >> 6) + 8 * i) * 1024 + 512 + hh * 64 + dd];
#pragma unroll
            for (int n = 0; n < 4; ++n)
#pragma unroll
                for (int j = 0; j < 4; ++j) ur[n][j] = zg[(size_t)(tok0 + w * 16 + 4 * q + j) * 1024 + hh * 64 + n * 16 + l15];
#pragma unroll
            for (int j = 0; j < 4; ++j) bsr[j] = b_s[hh * 128 + w * 16 + 4 * q + j];
            if (tid < 128) { const f32x4* p = (const f32x4*)(lnst + (size_t)(tok0 + tid) * 16); sta = p[0]; stb = p[1]; stc = p[2]; std_ = p[3]; }
            __syncthreads();
            if (tid < 128) {
                const float s1 = ((sta[0] + sta[2]) + (stb[0] + stb[2])) + ((stc[0] + stc[2]) + (std_[0] + std_[2]));
                const float s2 = ((sta[1] + sta[3]) + (stb[1] + stb[3])) + ((stc[1] + stc[3]) + (std_[1] + std_[3]));
                const float mean = s1 * (1.0f / 512.0f); const float var = fmaxf(s2 * (1.0f / 512.0f) - mean * mean, 0.f);
                st[tid] = mean; st[128 + tid] = 1.0f / sqrtf(var + 1e-5f);
            }
            __syncthreads();
            {
                const float gg = ln_g[hh * 64 + dd], bb = ln_b[hh * 64 + dd];
#pragma unroll
                for (int i = 0; i < 16; ++i) { const int s_ = (tid >> 6) + 8 * i;
                    vT[dd * AS + s_] = f2bf((bf2f(vr[i]) - st[s_]) * st[128 + s_] * gg + bb); }
            }
            __syncthreads();
            f32x4 acc[4];
#pragma unroll
            for (int n = 0; n < 4; ++n) acc[n] = (f32x4){0.f, 0.f, 0.f, 0.f};
            for (int ks = 0; ks < 4; ++ks) {
                if (ks * 32 > w * 16 + 15) break;
                const bf16x8 a = *(const LAS bf16x8*)(Aw + (w * 16 + l15) * AS + ks * 32 + q * 8);
#pragma unroll
                for (int n = 0; n < 4; ++n) {
                    const bf16x8 b = *(const LAS bf16x8*)(vT + (n * 16 + l15) * AS + ks * 32 + q * 8);
                    acc[n] = __builtin_amdgcn_mfma_f32_16x16x32_bf16(a, b, acc[n], 0, 0, 0);
                }
            }
#pragma unroll
            for (int n = 0; n < 4; ++n)
#pragma unroll
                for (int j = 0; j < 4; ++j) {
                    const int t = w * 16 + 4 * q + j, d = n * 16 + l15;
                    ycat[(size_t)(tok0 + t) * D_ + 512 + hh * 64 + d] = f2bf(bf2f(ur[n][j]) * (acc[n][j] + bsr[j]));
                }
        }
    }
    __syncthreads();
}

template <bool BT>
__device__ __forceinline__ void mm_lds(f32x4 (&acc)[2], const LAS float* A, const LAS float* B, int mrow, int nc0, int q) {
#pragma unroll
    for (int k0 = 0; k0 < 64; k0 += 16) {
        const f32x4 a = *(const LAS f32x4*)(A + mrow * MS + k0 + 4 * q);
        f32x4 b0, b1;
        if (BT) { b0 = *(const LAS f32x4*)(B + nc0 * MS + k0 + 4 * q); b1 = *(const LAS f32x4*)(B + (nc0 + 16) * MS + k0 + 4 * q); }
        else {
#pragma unroll
            for (int j = 0; j < 4; ++j) { b0[j] = B[(k0 + 4 * q + j) * MS + nc0]; b1[j] = B[(k0 + 4 * q + j) * MS + nc0 + 16]; }
        }
#pragma unroll
        for (int j = 0; j < 4; ++j) {
            acc[0] = __builtin_amdgcn_mfma_f32_16x16x4f32(a[j], b0[j], acc[0], 0, 0, 0);
            acc[1] = __builtin_amdgcn_mfma_f32_16x16x4f32(a[j], b1[j], acc[1], 0, 0, 0);
        }
    }
}
__device__ __forceinline__ void rwkv_phase_b1(const Ctx& C) {
    const float* Pg = (const float*)(C.ws + WS_P); const float* Qg = (const float*)(C.ws + WS_Q);
    float* Pc = (float*)(C.ws + WS_PC); float* Qc = (float*)(C.ws + WS_QC);
    const int w = C.wave;
    const int mt = w >> 1, nt0 = (w & 1) * 2;
    for (int item = C.bid; item < 8 * NGRP; item += C.G) {
        int tid = C.tid; asm volatile("" : "+v"(tid));
        const int lane = tid & 63, q = lane >> 4, l15 = lane & 15, mrow = mt * 16 + l15, nc0 = nt0 * 16 + l15;
        const int h = item & 7, g = item >> 3;
        const int e0 = tid, e1 = tid + NTHR;
        const int r0 = e0 >> 4, c0 = (e0 & 15) * 4, r1 = e1 >> 4, c1 = (e1 & 15) * 4;
        {
            const f32x4* P4 = (const f32x4*)(Pg + (size_t)((g * GCH) * 8 + h) * 4096); const f32x4* Q4 = (const f32x4*)(Qg + (size_t)((g * GCH) * 8 + h) * 4096);
            const f32x4* N4 = (const f32x4*)(Pg + (size_t)((g * GCH + 1) * 8 + h) * 4096);
            *(LAS f32x4*)(MAT(0) + r0 * MS + c0) = P4[e0]; *(LAS f32x4*)(MAT(0) + r1 * MS + c1) = P4[e1];
            *(LAS f32x4*)(MAT(1) + r0 * MS + c0) = Q4[e0]; *(LAS f32x4*)(MAT(1) + r1 * MS + c1) = Q4[e1];
            *(LAS f32x4*)(MAT(2) + r0 * MS + c0) = N4[e0]; *(LAS f32x4*)(MAT(2) + r1 * MS + c1) = N4[e1];
        }
        __syncthreads();
        for (int cc = 1; cc < GCH; ++cc) {
            const LAS float* Pb = MAT(2 + ((cc - 1) & 1)); LAS float* Pn = MAT(2 + (cc & 1));
            const float* Qi = Qg + (size_t)((g * GCH + cc) * 8 + h) * 4096;
            f32x4 n0 = (f32x4){0.f, 0.f, 0.f, 0.f}, n1 = n0;
            if (cc + 1 < GCH) { const f32x4* N4 = (const f32x4*)(Pg + (size_t)((g * GCH + cc + 1) * 8 + h) * 4096); n0 = N4[e0]; n1 = N4[e1]; }
            float qv[2][4];
#pragma unroll
            for (int i = 0; i < 2; ++i)
#pragma unroll
                for (int j = 0; j < 4; ++j) qv[i][j] = Qi[(mt * 16 + 4 * q + j) * 64 + nc0 + 16 * i];
            f32x4 xp[2], xq[2]; ZACC(xp); ZACC(xq);
            mm_lds<false>(xp, MAT(0), Pb, mrow, nc0, q);
            mm_lds<false>(xq, MAT(1), Pb, mrow, nc0, q);
            __syncthreads();
#pragma unroll
            for (int i = 0; i < 2; ++i)
#pragma unroll
                for (int j = 0; j < 4; ++j) { const int r = mt * 16 + 4 * q + j, c2 = nc0 + 16 * i;
                    MAT(0)[r * MS + c2] = xp[i][j]; MAT(1)[r * MS + c2] = xq[i][j] + qv[i][j]; }
            if (cc + 1 < GCH) { *(LAS f32x4*)(Pn + r0 * MS + c0) = n0; *(LAS f32x4*)(Pn + r1 * MS + c1) = n1; }
            __syncthreads();
        }
        {
            f32x4* P4 = (f32x4*)(Pc + (size_t)(h * NGRP + g) * 4096); f32x4* Q4 = (f32x4*)(Qc + (size_t)(h * NGRP + g) * 4096);
            P4[e0] = *(const LAS f32x4*)(MAT(0) + r0 * MS + c0); P4[e1] = *(const LAS f32x4*)(MAT(0) + r1 * MS + c1);
            Q4[e0] = *(const LAS f32x4*)(MAT(1) + r0 * MS + c0); Q4[e1] = *(const LAS f32x4*)(MAT(1) + r1 * MS + c1);
        }
        __syncthreads();
    }
}
__device__ __forceinline__ void rwkv_phase_b2(const Ctx& C) {
    const float* Pc = (const float*)(C.ws + WS_PC); const float* Qc = (const float*)(C.ws + WS_QC); float* Sg = (float*)(C.ws + WS_SG);
    const int tid = C.tid, lane = C.lane, w = C.wave, q = lane >> 4, l15 = lane & 15;
    for (int item = C.bid; item < 32; item += C.G) {
        const int h = item >> 2, rb = item & 3;
        for (int e = tid; e < 1024; e += NTHR) MAT(0)[(e >> 6) * MS + (e & 63)] = 0.f;
        float pv[4][16], qv[4][4];
        const size_t ob = (size_t)(h * NGRP) * 4096;
        const int poff = (4 * q) * 64 + w * 16 + l15, qoff = (rb * 16 + 4 * q) * 64 + w * 16 + l15;
        if (w < 4) {
#pragma unroll
            for (int s = 0; s < 4; ++s) {
#pragma unroll
                for (int i = 0; i < 16; ++i) pv[s][i] = Pc[ob + (size_t)s * 4096 + poff + ((i & 3) + 16 * (i >> 2)) * 64];
#pragma unroll
                for (int j = 0; j < 4; ++j) qv[s][j] = Qc[ob + (size_t)s * 4096 + qoff + j * 64];
            }
        }
        __syncthreads();
        for (int g0 = 0; g0 < NGRP; g0 += 4) {
#pragma unroll
            for (int s = 0; s < 4; ++s) {
                const int g = g0 + s; const size_t o = ob + (size_t)g * 4096;
                for (int e = tid; e < 1024; e += NTHR) Sg[o + (rb * 16 + (e >> 6)) * 64 + (e & 63)] = MAT(0)[(e >> 6) * MS + (e & 63)];
                f32x4 a0 = (f32x4){0.f, 0.f, 0.f, 0.f}, a1 = a0; float qc[4];
                if (w < 4) {
                    const LAS float* m0 = MAT(0);
#pragma unroll
                    for (int kb = 0; kb < 4; kb += 2) {
                        const f32x4 s0 = *(const LAS f32x4*)(m0 + l15 * MS + 16 * kb + 4 * q), s1 = *(const LAS f32x4*)(m0 + l15 * MS + 16 * (kb + 1) + 4 * q);
#pragma unroll
                        for (int j = 0; j < 4; ++j) {
                            a0 = __builtin_amdgcn_mfma_f32_16x16x4f32(s0[j], pv[s][4 * kb + j], a0, 0, 0, 0);
                            a1 = __builtin_amdgcn_mfma_f32_16x16x4f32(s1[j], pv[s][4 * (kb + 1) + j], a1, 0, 0, 0);
                        }
                    }
#pragma unroll
                    for (int j = 0; j < 4; ++j) qc[j] = qv[s][j];
                    if (g + 4 < NGRP) {
#pragma unroll
                        for (int i = 0; i < 16; ++i) pv[s][i] = Pc[o + 4 * 4096 + poff + ((i & 3) + 16 * (i >> 2)) * 64];
#pragma unroll
                        for (int j = 0; j < 4; ++j) qv[s][j] = Qc[o + 4 * 4096 + qoff + j * 64];
                    }
                }
                __syncthreads();
                if (w < 4) {
#pragma unroll
                    for (int j = 0; j < 4; ++j) { const int r = 4 * q + j, c2 = w * 16 + l15; MAT(0)[r * MS + c2] = a0[j] + a1[j] + qc[j]; }
                }
                __syncthreads();
            }
        }
    }
}
__device__ __forceinline__ void rwkv_phase_c(const Ctx& C) {
    const bf16_t* zr = (const bf16_t*)(C.ws + WS_ZR); const float* mu = C.in[8]; const float* gn_g = C.in[17]; const float* gn_b = C.in[18];
    const float* Pg = (const float*)(C.ws + WS_P); const float* Qg = (const float*)(C.ws + WS_Q); const bf16_t* Y0g = (const bf16_t*)(C.ws + WS_Y0);
    const bf16_t* Rcg = (const bf16_t*)(C.ws + WS_RC); const bf16_t* Gg = (const bf16_t*)(C.ws + WS_G); const float* bon = (const float*)(C.ws + WS_BON);
    const float* Sg = (const float*)(C.ws + WS_SG); bf16_t* ycat = (bf16_t*)(C.ws + WS_ACTA);
    LAS bf16_t* SH = (LAS bf16_t*)MAT(4); LAS bf16_t* SL = (LAS bf16_t*)MAT(5);
    const int w = C.wave;
    const int mt = w >> 1, nt0 = (w & 1) * 2;
    for (int item = C.bid; item < 8 * NGRP; item += C.G) {
        int tid = C.tid; asm volatile("" : "+v"(tid));
        const int lane = tid & 63, q = lane >> 4, l15 = lane & 15, mrow = mt * 16 + l15, nc0 = nt0 * 16 + l15;
        const int ci = tid & 63, tg8 = tid >> 6;
        const int h = item & 7, g = item >> 3;
        const int e0 = tid, e1 = tid + NTHR;
        const int r0 = e0 >> 4, c0 = (e0 & 15) * 4, r1 = e1 >> 4, c1 = (e1 & 15) * 4;
        const int rr8 = tid >> 3, cc8 = (tid & 7) * 8;
        {
            const f32x4* S4 = (const f32x4*)(Sg + (size_t)(h * NGRP + g) * 4096);
            const f32x4 sa = S4[e0], sb = S4[e1];
            *(LAS f32x4*)(MAT(0) + r0 * MS + c0) = sa; *(LAS f32x4*)(MAT(0) + r1 * MS + c1) = sb;
            { u32x2 hi; hi.x = pk2(sa[0], sa[1]); hi.y = pk2(sa[2], sa[3]); const f32x4 rs = sa - bflo4(hi.x, hi.y); u32x2 lo; lo.x = pk2(rs[0], rs[1]); lo.y = pk2(rs[2], rs[3]);
              *(LAS u32x2*)(SH + r0 * BS + c0) = hi; *(LAS u32x2*)(SL + r0 * BS + c0) = lo; }
            { u32x2 hi; hi.x = pk2(sb[0], sb[1]); hi.y = pk2(sb[2], sb[3]); const f32x4 rs = sb - bflo4(hi.x, hi.y); u32x2 lo; lo.x = pk2(rs[0], rs[1]); lo.y = pk2(rs[2], rs[3]);
              *(LAS u32x2*)(SH + r1 * BS + c1) = hi; *(LAS u32x2*)(SL + r1 * BS + c1) = lo; }
            const size_t io = (size_t)((g * GCH) * 8 + h) * 4096;
            const f32x4* P4 = (const f32x4*)(Pg + io);
            *(LAS f32x4*)(MAT(2) + r0 * MS + c0) = P4[e0]; *(LAS f32x4*)(MAT(2) + r1 * MS + c1) = P4[e1];
            *(LAS u32x4*)((LAS bf16_t*)MAT(6) + rr8 * BS + cc8) = ((const u32x4*)(Rcg + io))[tid];
        }
        const float gg = gn_g[h * 64 + ci], gb = gn_b[h * 64 + ci], muv = mu[1024 + h * 64 + ci];
        __syncthreads();
        for (int cc = 0; cc < GCH; ++cc) {
            const int c = g * GCH + cc, tok0 = c * 64; const size_t io = (size_t)(c * 8 + h) * 4096;
            const float* Qi = Qg + io; const bf16_t* Yi = Y0g + io;
            const LAS float* Pb = MAT(2 + (cc & 1)); const LAS bf16_t* Rb = (const LAS bf16_t*)MAT(6 + (cc & 1));
            f32x4 n0 = (f32x4){0.f, 0.f, 0.f, 0.f}, n1 = n0; u32x4 rn = (u32x4){0u, 0u, 0u, 0u};
            if (cc + 1 < GCH) { const f32x4* P4 = (const f32x4*)(Pg + io + 8 * 4096); n0 = P4[e0]; n1 = P4[e1]; rn = ((const u32x4*)(Rcg + io + 8 * 4096))[tid]; }
            float qv[2][4], yv[2][4];
#pragma unroll
            for (int i = 0; i < 2; ++i)
#pragma unroll
                for (int j = 0; j < 4; ++j) { const int r = mt * 16 + 4 * q + j, c2 = nc0 + 16 * i; qv[i][j] = Qi[r * 64 + c2]; yv[i][j] = bf2f(Yi[r * 64 + c2]); }
            float vv[8], bo[8], gt[8];
#pragma unroll
            for (int u = 0; u < 8; ++u) { const int tok = tok0 + tg8 * 8 + u; vv[u] = zshift(zr, tok, 1024 + h * 64 + ci, muv); bo[u] = bon[(size_t)tok * 8 + h]; gt[u] = bf2f(Gg[(size_t)tok * GWD_ + h * 64 + ci]); }
            f32x4 xy[2], xs[2]; ZACC(xy); ZACC(xs);
#pragma unroll
            for (int ks = 0; ks < 2; ++ks) {
                const bf16x8 a = *(const LAS bf16x8*)(Rb + mrow * BS + ks * 32 + q * 8);
                const bf16x8 h0 = *(const LAS bf16x8*)(SH + nc0 * BS + ks * 32 + q * 8), h1 = *(const LAS bf16x8*)(SH + (nc0 + 16) * BS + ks * 32 + q * 8);
                const bf16x8 l0 = *(const LAS bf16x8*)(SL + nc0 * BS + ks * 32 + q * 8), l1 = *(const LAS bf16x8*)(SL + (nc0 + 16) * BS + ks * 32 + q * 8);
                xy[0] = __builtin_amdgcn_mfma_f32_16x16x32_bf16(a, h0, xy[0], 0, 0, 0); xy[1] = __builtin_amdgcn_mfma_f32_16x16x32_bf16(a, h1, xy[1], 0, 0, 0);
                xy[0] = __builtin_amdgcn_mfma_f32_16x16x32_bf16(a, l0, xy[0], 0, 0, 0); xy[1] = __builtin_amdgcn_mfma_f32_16x16x32_bf16(a, l1, xy[1], 0, 0, 0);
            }
            mm_lds<false>(xs, MAT(0), Pb, mrow, nc0, q);
#pragma unroll
            for (int i = 0; i < 2; ++i)
#pragma unroll
                for (int j = 0; j < 4; ++j) { const int r = mt * 16 + 4 * q + j, c2 = nc0 + 16 * i; MAT(1)[r * MS + c2] = xy[i][j] + yv[i][j]; }
            __syncthreads();
#pragma unroll
            for (int i = 0; i < 2; ++i)
#pragma unroll
                for (int j = 0; j < 4; ++j) { const int r = mt * 16 + 4 * q + j, c2 = nc0 + 16 * i; const float sv = xs[i][j] + qv[i][j];
                    MAT(0)[r * MS + c2] = sv; const bf16_t hb = f2bf(sv); SH[r * BS + c2] = hb; SL[r * BS + c2] = f2bf(sv - bf2f(hb)); }
            if (cc + 1 < GCH) {
                LAS float* Pn = MAT(2 + ((cc + 1) & 1));
                *(LAS f32x4*)(Pn + r0 * MS + c0) = n0; *(LAS f32x4*)(Pn + r1 * MS + c1) = n1;
                *(LAS u32x4*)((LAS bf16_t*)MAT(6 + ((cc + 1) & 1)) + rr8 * BS + cc8) = rn;
            }
#pragma unroll
            for (int u = 0; u < 8; ++u) {
                const int t = tg8 * 8 + u, tok = tok0 + t;
                const float y = MAT(1)[t * MS + ci];
                const float mean = wave_sum(y) * (1.0f / 64.0f); const float dlt = y - mean;
                const float var = wave_sum(dlt * dlt) * (1.0f / 64.0f);
                const float yn = dlt * (1.0f / sqrtf(var + 64e-5f)) * gg + gb;
                ycat[(size_t)tok * D_ + h * 64 + ci] = f2bf((yn + bo[u] * vv[u]) * gt[u]);
            }
            __syncthreads();
        }
    }
}


__device__ __forceinline__ void phase0(const Ctx& C) {
    LAS float* scr = (LAS float*)(C.lds + C.wave * 8448);
    const int gw = C.bid * 8 + C.wave, NGW = C.G * 8, lane = C.lane;
    bf16_t* W13 = (bf16_t*)(C.ws + WS_W13A); bf16_t* W2 = (bf16_t*)(C.ws + WS_W2A); bf16_t* Win = (bf16_t*)(C.ws + WS_WIN); bf16_t* Wout = (bf16_t*)(C.ws + WS_WOUT);
    bf16_t* wdecT = (bf16_t*)(C.ws + WS_LORA); bf16_t* waaaT = wdecT + 512 * 64; bf16_t* wgateT = waaaT + 512 * 64;
    constexpr int I1 = 16 * 88, NIT = 2 * I1 + 64;
    for (int it = gw; it < NIT; it += NGW) {
        int r = it;
        if (r < 16) { transpose_item(C.in[10], 64, 512, nullptr, wdecT, 0, scr, r, lane); continue; } r -= 16;
        if (r < 16) { transpose_item(C.in[12], 64, 512, nullptr, waaaT, 0, scr, r, lane); continue; } r -= 16;
        if (r < 32) { transpose_item(C.in[13], 128, 512, nullptr, wgateT, 0, scr, r, lane); continue; } r -= 32;
        if (r < I1) { transpose_item(C.in[3], D_, FF_, C.in[2], W13, 1, scr, r, lane); continue; } r -= I1;
        transpose_item(C.in[4], D_, FF_, C.in[2], W13, 2, scr, r, lane);
    }
    const float* x = C.in[0]; bf16_t* xb = (bf16_t*)(C.ws + WS_ACTA); float* ssq = (float*)(C.ws + WS_SSQA);
    for (int row = gw; row < T_; row += 4 * NGW) {
        f32x4 v[4][4];
#pragma unroll
        for (int r = 0; r < 4; ++r) { const int rw = (row + r * NGW < T_) ? row + r * NGW : row; const f32x4* xa = (const f32x4*)(x + (size_t)rw * D_) + lane;
#pragma unroll
            for (int j = 0; j < 4; ++j) v[r][j] = xa[64 * j]; }
#pragma unroll
        for (int r = 0; r < 4; ++r) {
            const int rw = row + r * NGW; const bool has = rw < T_;
            float s = 0.f; u32x2* oa = (u32x2*)(xb + (size_t)(has ? rw : row) * D_) + lane;
#pragma unroll
            for (int j = 0; j < 4; ++j) {
                s += (v[r][j][0] * v[r][j][0] + v[r][j][1] * v[r][j][1]) + (v[r][j][2] * v[r][j][2] + v[r][j][3] * v[r][j][3]);
                if (has) { u32x2 w; w.x = pk2(v[r][j][0], v[r][j][1]); w.y = pk2(v[r][j][2], v[r][j][3]); oa[64 * j] = w; }
            }
            s = wave_sum(s);
            if (has && lane < 16) ssq[(size_t)rw * 16 + lane] = lane == 0 ? s : 0.f;
        }
    }
}
__device__ __forceinline__ void convert_mid(const Ctx& C, int vbid, int vG) {
    LAS float* scr = (LAS float*)(C.lds + C.wave * 8448);
    const int gw = vbid * 8 + C.wave, NGW = vG * 8, lane = C.lane;
    bf16_t* W2 = (bf16_t*)(C.ws + WS_W2A); bf16_t* Win = (bf16_t*)(C.ws + WS_WIN); bf16_t* Wout = (bf16_t*)(C.ws + WS_WOUT);
    constexpr int I1 = 16 * 88, I2 = 44 * 32, IO = 16 * 32, NIT = I1 + I2 + IO;
    for (int it = gw; it < NIT; it += NGW) {
        int r = it;
        if (r < I2) { transpose_item(C.in[5], FF_, D_, nullptr, W2, 0, scr, r, lane); continue; } r -= I2;
        if (r < I1) { transpose_item(C.in[7], D_, FF_, C.in[6], Win, 0, scr, r, lane); continue; } r -= I1;
        transpose_item(C.in[23], D_, D_, nullptr, Wout, 0, scr, r, lane);
    }
}
__device__ __forceinline__ void convert_w13b(const Ctx& C) {
    LAS float* scr = (LAS float*)(C.lds + C.wave * 8448);
    const int gw = C.bid * 8 + C.wave, NGW = C.G * 8, lane = C.lane;
    bf16_t* W13 = (bf16_t*)(C.ws + WS_W13B);
    constexpr int I1 = 16 * 88;
    for (int it = gw; it < 2 * I1; it += NGW) {
        if (it < I1) transpose_item(C.in[25], D_, FF_, C.in[24], W13, 1, scr, it, lane);
        else transpose_item(C.in[26], D_, FF_, C.in[24], W13, 2, scr, it - I1, lane);
    }
}
__device__ __forceinline__ void convert_late(const Ctx& C, int vbid, int vG) {
    LAS float* scr = (LAS float*)(C.lds + C.wave * 8448);
    const int gw = vbid * 8 + C.wave, NGW = vG * 8, lane = C.lane;
    bf16_t* W2 = (bf16_t*)(C.ws + WS_W2B); bf16_t* Wg = (bf16_t*)(C.ws + WS_WG); bf16_t* Wple = (bf16_t*)(C.ws + WS_WPLE);
    constexpr int I2 = 44 * 32, IG = 16 * 32, IP = 4 * 32, NIT = I2 + IG + IP;
    for (int it = gw; it < NIT; it += NGW) {
        int r = it;
        if (r < I2) { transpose_item(C.in[27], FF_, D_, nullptr, W2, 0, scr, r, lane); continue; } r -= I2;
        if (r < IG) { transpose_item(C.in[29], D_, D_, C.in[28], Wg, 0, scr, r, lane); continue; } r -= IG;
        transpose_item(C.in[30], 256, D_, nullptr, Wple, 0, scr, r, lane);
    }
    const float* p = C.in[1]; bf16_t* pb = (bf16_t*)(C.ws + WS_PB);
    for (int row = gw; row < T_ / 4; row += NGW) {
        const f32x4* xr = (const f32x4*)(p + (size_t)row * 1024) + lane; u32x2* o8 = (u32x2*)(pb + (size_t)row * 1024) + lane;
#pragma unroll
        for (int j = 0; j < 4; ++j) { const f32x4 v = xr[64 * j]; u32x2 w; w.x = pk2(v[0], v[1]); w.y = pk2(v[2], v[3]); o8[64 * j] = w; }
    }
}
__device__ __forceinline__ void final_norm(const Ctx& C) {
    const int gw = C.bid * 8 + C.wave, NGW = C.G * 8, lane = C.lane;
    const float* ssq = (const float*)(C.ws + WS_SSQA); const float* gf = C.in[31]; const bf16_t* h4 = (const bf16_t*)(C.ws + WS_H4);
    f32x4 gv[4];
#pragma unroll
    for (int j = 0; j < 4; ++j) gv[j] = ((const f32x4*)gf)[lane + 64 * j];
    for (int row = gw; row < T_; row += NGW) {
        const float rs = row_rstd(ssq, row);
        f32x4* xr = (f32x4*)(C.out + (size_t)row * D_) + lane; const u32x2* hr = (const u32x2*)(h4 + (size_t)row * D_) + lane;
#pragma unroll
        for (int j = 0; j < 4; ++j) { const u32x2 hw = hr[64 * j];
            f32x4 v = (f32x4){__uint_as_float(hw.x << 16), __uint_as_float(hw.x & 0xffff0000u), __uint_as_float(hw.y << 16), __uint_as_float(hw.y & 0xffff0000u)};
            xr[64 * j] = v * rs * gv[j]; }
    }
}

#define XB_TMO      128
#define XB_XCNT(j)  (256  + 64 * (j))
#define XB_XSUB(j)  (1280 + 64 * (j))
#define XB_XGEN(j)  (2304 + 64 * (j))
#define XB_TOP      3328
#define XB_TOPGEN   3392
#define XCD_BAR_WORDS 3456
#define XB_SPIN_CAP (1u << 18)

__device__ __forceinline__ unsigned xb_ld(unsigned* p)              { return __hip_atomic_load(p, __ATOMIC_RELAXED, __HIP_MEMORY_SCOPE_AGENT); }
__device__ __forceinline__ unsigned xb_add(unsigned* p, unsigned v) { return __hip_atomic_fetch_add(p, v, __ATOMIC_RELAXED, __HIP_MEMORY_SCOPE_AGENT); }
__device__ __forceinline__ unsigned xb_xcc_id() { return (unsigned)__builtin_amdgcn_s_getreg((3 << 11) | 20) & 0xFu; }
#define XB_SPIN(cond, bar) do { unsigned _sp = 0; while (cond) { __builtin_amdgcn_s_sleep(1); \
    if ((++_sp & 255u) == 0u) { if (xb_ld(&(bar)[XB_TMO])) break; if (_sp > XB_SPIN_CAP) { atomicAdd(&(bar)[XB_TMO], 1u); break; } } } } while (0)
struct XcdBarrier {
    unsigned* bar; unsigned x;
    volatile LAS unsigned* st;
};

__device__ __forceinline__ XcdBarrier xcd_barrier_post(unsigned* bar, volatile LAS unsigned* st) {
    XcdBarrier b; b.bar = bar; b.x = xb_xcc_id(); b.st = st;
    if (threadIdx.x == 0) (void)xb_add(&bar[XB_XCNT(b.x)], 1u);
    return b;
}
__device__ __forceinline__ void xcd_barrier_complete(unsigned* bar, unsigned x, unsigned& nloc, unsigned& nx) {
    const unsigned G = gridDim.x * gridDim.y * gridDim.z;
    unsigned sum, cnt, mine, sp = 0u;
    for (;;) {
        sum = 0u; cnt = 0u; mine = 0u;
#pragma unroll
        for (unsigned j = 0; j < 16; ++j) { const unsigned c = xb_ld(&bar[XB_XCNT(j)]); sum += c; cnt += (c > 0u) ? 1u : 0u; mine = (j == x) ? c : mine; }
        if (sum == G) break;
        __builtin_amdgcn_s_sleep(1);
        if ((++sp & 255u) == 0u) { if (xb_ld(&bar[XB_TMO])) break; if (sp > XB_SPIN_CAP) { atomicAdd(&bar[XB_TMO], 1u); break; } }
    }
    nloc = mine > 0u ? mine : 1u; nx = cnt > 0u ? cnt : 1u;
}

__device__ __forceinline__ void xcd_barrier(const XcdBarrier& b) {
    asm volatile("s_waitcnt vmcnt(0)" ::: "memory");
    __syncthreads();
    if (threadIdx.x == 0) {
        unsigned* bar = b.bar;
        __builtin_amdgcn_s_waitcnt(0);
        unsigned nloc = b.st[0], nx = b.st[1];
        if (nloc == 0u) { xcd_barrier_complete(bar, b.x, nloc, nx); b.st[0] = nloc; b.st[1] = nx; }
        const unsigned old = xb_add(&bar[XB_XSUB(b.x)], 1u);
        const unsigned gen = old / nloc;
        if (old + 1u == (gen + 1u) * nloc) {
            __builtin_amdgcn_fence(__ATOMIC_RELEASE, "agent");
            asm volatile("s_waitcnt vmcnt(0)" ::: "memory");
            const unsigned og = xb_add(&bar[XB_TOP], 1u);
            const unsigned tg = og / nx;
            if (og + 1u == (tg + 1u) * nx) xb_add(&bar[XB_TOPGEN], 1u);
            else XB_SPIN(xb_ld(&bar[XB_TOPGEN]) == tg, bar);
            __builtin_amdgcn_fence(__ATOMIC_ACQUIRE, "agent");
            xb_add(&bar[XB_XGEN(b.x)], 1u);
            asm volatile("s_waitcnt vmcnt(0)" ::: "memory");
        } else {
            XB_SPIN(xb_ld(&bar[XB_XGEN(b.x)]) == gen, bar);
            __builtin_amdgcn_fence(__ATOMIC_ACQUIRE, "agent");
            asm volatile("s_waitcnt vmcnt(0)" ::: "memory");
        }
    }
    __syncthreads();
}

constexpr size_t WS_BAR = 255 * MiB;
constexpr int ST_OFF = LDS_BYTES - 16;

#ifndef X_RESID_BF16
#define X_RESID_BF16 1
#endif
#ifndef KEEP_LO1
#define KEEP_LO1 false
#endif
#ifndef KEEP_LO2
#define KEEP_LO2 false
#endif
#ifndef KEEP_LO3
#define KEEP_LO3 false
#endif
struct Args { const float* in[32]; float* out; unsigned char* ws; int ph_lo, ph_hi, flags, pad; };

__global__ void __launch_bounds__(NTHR, 2) fwd_kernel(Args args) {
    __builtin_assume(__builtin_amdgcn_workitem_id_y() == 0); __builtin_assume(__builtin_amdgcn_workitem_id_z() == 0);
    extern __shared__ __attribute__((aligned(16))) unsigned char lds_raw[];
    cg::grid_group grid = cg::this_grid();
    Ctx C;
    C.lds = (LAS unsigned char*)lds_raw; C.tid = threadIdx.x; C.lane = C.tid & 63; C.wave = __builtin_amdgcn_readfirstlane(C.tid >> 6);
    C.G = gridDim.x; C.bid = blockIdx.x; C.in = args.in; C.out = args.out; C.ws = args.ws;
    const int lo = args.ph_lo, hi = args.ph_hi;
    if (threadIdx.x < 4) ((LAS unsigned*)(C.lds + ST_OFF))[threadIdx.x] = 0u;
    __syncthreads();
    XcdBarrier xbar = xcd_barrier_post((unsigned*)(args.ws + WS_BAR), (volatile LAS unsigned*)(C.lds + ST_OFF));
    unsigned char* ws = args.ws;
    bf16_t* actA = (bf16_t*)(ws + WS_ACTA); bf16_t* actB = (bf16_t*)(ws + WS_ACTB); bf16_t* hid = (bf16_t*)(ws + WS_HID);
    float* ssqA = (float*)(ws + WS_SSQA); float* ssqB = (float*)(ws + WS_SSQB);
    bf16_t* hlo3 = (bf16_t*)(ws + 184 * MiB);
    bf16_t* hlo = (bf16_t*)args.out;
    bf16_t* hhi1 = hlo + (size_t)T_ * D_;
#define IN(k) (lo <= (k) && (k) < hi)
#define SEAM(k) do { if (IN(k) && IN((k) + 1)) xcd_barrier(xbar); } while (0)

    if (IN(0)) { phase0(C); } SEAM(0);
    if (IN(1)) {
        pg8::Gemm g{actA, (const bf16_t*)(ws + WS_W13A), T_, 2 * FF_, D_}; pg8::StaticOrder S; S.init(T_, 2 * FF_, C.G, C.bid);
        EpiSwiGLU E{hid, ssqA};
        pg8::gemm_phase<EpiSwiGLU, pg8::StaticOrder, true, true>(C.lds, g, S, E);
        { const int rem = S.nwg % C.G; __syncthreads(); if (rem == 0) convert_mid(C, C.bid, C.G); else if (C.bid >= rem) convert_mid(C, C.bid - rem, C.G - rem); }
    } SEAM(1);
    if (IN(2)) {
        pg8::Gemm g{hid, (const bf16_t*)(ws + WS_W2A), T_, D_, FF_}; pg8::StaticOrder S; S.init(T_, D_, C.G, C.bid);
#if X_RESID_BF16
        EpiResid<1, false, KEEP_LO1> E{nullptr, actA, nullptr, hlo, hhi1, ssqB, 0.5f};
        pg8::gemm_phase<EpiResid<1, false, KEEP_LO1>, pg8::StaticOrder, false, true>(C.lds, g, S, E);
#else
        EpiResid<0, false, KEEP_LO1> E{args.in[0], nullptr, nullptr, hlo, hhi1, ssqB, 0.5f};
        pg8::gemm_phase<EpiResid<0, false, KEEP_LO1>, pg8::StaticOrder, false, true>(C.lds, g, S, E);
#endif
    } SEAM(2);
    if (IN(3)) {
        pg8::Gemm g{hhi1, (const bf16_t*)(ws + WS_WIN), T_, FF_, D_}; pg8::StaticOrder S; S.init(T_, FF_, C.G, C.bid);
        EpiZ E{(bf16_t*)(ws + WS_ZR), (bf16_t*)(ws + WS_ZG), ssqB, (float*)(ws + WS_LNST)};
        pg8::gemm_phase<EpiZ, pg8::StaticOrder, true, true>(C.lds, g, S, E);
    } SEAM(3);
    if (IN(4)) { rwkv_phase_a(C); } SEAM(4);
    if (IN(5)) { rwkv_phase_b1(C); } SEAM(5);
    if (IN(6)) {
        if (C.G >= 64) { if (C.bid < 32) rwkv_phase_b2(C); else { Ctx C2 = C; C2.bid = C.bid - 32; C2.G = C.G - 32; gmlp_phase(C2); } }
        else { rwkv_phase_b2(C); __syncthreads(); gmlp_phase(C); }
    } SEAM(6);
    if (IN(7)) { rwkv_phase_c(C); } SEAM(7);
    if (IN(8)) {
        convert_w13b(C); __syncthreads();
        pg8::Gemm g{actA, (const bf16_t*)(ws + WS_WOUT), T_, D_, D_}; pg8::StaticOrder S; S.init(T_, D_, C.G, C.bid);
        EpiResid<1, KEEP_LO1, KEEP_LO2> E{nullptr, hhi1, hlo, hlo, actB, ssqA, 1.0f};
        pg8::gemm_phase<EpiResid<1, KEEP_LO1, KEEP_LO2>, pg8::StaticOrder, false, true>(C.lds, g, S, E);
    } SEAM(8);
    if (IN(9)) {
        pg8::Gemm g{actB, (const bf16_t*)(ws + WS_W13B), T_, 2 * FF_, D_}; pg8::StaticOrder S; S.init(T_, 2 * FF_, C.G, C.bid);
        EpiSwiGLU E{hid, ssqA};
        pg8::gemm_phase<EpiSwiGLU, pg8::StaticOrder, true, true>(C.lds, g, S, E);
        { const int rem = S.nwg % C.G; __syncthreads(); if (rem == 0) convert_late(C, C.bid, C.G); else if (C.bid >= rem) convert_late(C, C.bid - rem, C.G - rem); }
    } SEAM(9);
    if (IN(10)) {
        pg8::Gemm g{hid, (const bf16_t*)(ws + WS_W2B), T_, D_, FF_}; pg8::StaticOrder S; S.init(T_, D_, C.G, C.bid);
        EpiResid<1, KEEP_LO2, KEEP_LO3> E{nullptr, actB, hlo, hlo3, actA, ssqB, 0.5f};
        pg8::gemm_phase<EpiResid<1, KEEP_LO2, KEEP_LO3>, pg8::StaticOrder, false, true>(C.lds, g, S, E);
    } SEAM(10);
    const bool fuse_final = (64 * 4 == C.G);
    if (IN(11)) {
        { pg8::Gemm g{(const bf16_t*)(ws + WS_PB), (const bf16_t*)(ws + WS_WPLE), T_, D_, 256}; pg8::StaticOrder S; S.init(T_, D_, C.G, C.bid);
          EpiPE E{(bf16_t*)(ws + WS_PE)};
          pg8::gemm_phase<EpiPE, pg8::StaticOrder, false, true>(C.lds, g, S, E); }
        __syncthreads();
        if (fuse_final) {
          pg8::Gemm g{actA, (const bf16_t*)(ws + WS_WG), T_, D_, D_}; pg8::StaticOrder S; S.init(T_, D_, C.G, C.bid);
          EpiGateFinal E{(const bf16_t*)(ws + WS_PE), actA, KEEP_LO3 ? hlo3 : nullptr, args.out, args.in[31], ssqB, ssqA, (unsigned*)(ws + WS_BAR + 16384)};
          pg8::gemm_phase<EpiGateFinal, pg8::StaticOrder, false, true>(C.lds, g, S, E);
        } else {
          pg8::Gemm g{actA, (const bf16_t*)(ws + WS_WG), T_, D_, D_}; pg8::StaticOrder S; S.init(T_, D_, C.G, C.bid);
          EpiGate E{(const bf16_t*)(ws + WS_PE), actA, KEEP_LO3 ? hlo3 : nullptr, (bf16_t*)(ws + WS_H4), ssqB, ssqA};
          pg8::gemm_phase<EpiGate, pg8::StaticOrder, false, true>(C.lds, g, S, E);
        }
    }
    if (!fuse_final) SEAM(11);
    if (IN(12) && !fuse_final) { final_norm(C); }
    if (hi > 64) grid.sync();
#undef IN
#undef SEAM
}

extern "C" void kernel_launch(void* const* d_in, const int* in_sizes, int n_in, void* d_out, int out_size, void* d_ws, size_t ws_size, hipStream_t stream) {
    static int grid = 0;
    if (grid == 0) {
        int dev = 0, cus = 0, per_cu = 0;
        hipGetDevice(&dev);
        hipDeviceGetAttribute(&cus, hipDeviceAttributeMultiprocessorCount, dev);
        if (hipFuncSetAttribute((const void*)fwd_kernel, hipFuncAttributeMaxDynamicSharedMemorySize, LDS_BYTES) != hipSuccess) fprintf(stderr, "hipFuncSetAttribute failed\n");
        hipOccupancyMaxActiveBlocksPerMultiprocessor(&per_cu, (const void*)fwd_kernel, NTHR, LDS_BYTES);
        if (per_cu < 1) { fprintf(stderr, "occupancy query says %d blocks/CU\n", per_cu); per_cu = 1; }
        if (per_cu > 1) per_cu = 1;
        grid = cus * per_cu;
        (void)hipGetLastError();
        if (ws_size < 254 * MiB) fprintf(stderr, "workspace too small: %zu\n", ws_size);
    }
    (void)hipMemsetAsync((char*)d_ws + WS_BAR, 0, 32768, stream);
    Args a{};
    for (int i = 0; i < 32; ++i) a.in[i] = (const float*)d_in[i];
    a.out = (float*)d_out; a.ws = (unsigned char*)d_ws;
#if defined(MK_MULTI)
    for (int ph = 0; ph < 13; ++ph) { a.ph_lo = ph; a.ph_hi = ph + 1; hipLaunchKernelGGL(fwd_kernel, dim3(grid), dim3(NTHR), LDS_BYTES, stream, a); }
#else
    a.ph_lo = 0; a.ph_hi = 13;
    void* kargs[] = {&a};
    hipError_t e = hipLaunchCooperativeKernel((const void*)fwd_kernel, dim3(grid), dim3(NTHR), kargs, LDS_BYTES, stream);
    if (e != hipSuccess) fprintf(stderr, "cooperative launch failed: %s (grid %d)\n", hipGetErrorString(e), grid);
#if defined(PROBE_PHASES)
    a.flags = PROBE_FLAGS; for (int ph = 0; ph < 13; ++ph) if ((PROBE_PHASES >> ph) & 1) { a.ph_lo = ph; a.ph_hi = ph + 1; hipLaunchKernelGGL(fwd_kernel, dim3(grid), dim3(NTHR), LDS_BYTES, stream, a); }
#endif
#endif
}
```

```cpp
#include <hip/hip_runtime.h>
#include <hip/hip_cooperative_groups.h>
#include <cstdio>
#include <cstdint>
namespace cg = cooperative_groups;

namespace pg8 {
#define PG8_LAS __attribute__((address_space(3)))
typedef unsigned short bf16_t;
typedef short bf16x8 __attribute__((ext_vector_type(8)));
typedef float f32x4 __attribute__((ext_vector_type(4)));
typedef unsigned u32x4 __attribute__((ext_vector_type(4)));
constexpr int BM = 256, BK = 64, HALF = 128, HTB = HALF * BK * 2  , STAGE_BYTES = 8 * HTB, NXCD = 8, WGM = 8;

__host__ __device__ __forceinline__ int lds_byte(int r, int c) { const int st = (r >> 4) * 2 + (c >> 5), rr = r & 15, cc = c & 31, ob = rr * 64 + cc * 2; return st * 1024 + (ob ^ (((ob >> 9) & 1) << 5)); }
__host__ __device__ __forceinline__ void stage_rc(int b, int& R, int& C) { const int st = b / 1024, sb = b % 1024, swz = sb ^ (((sb >> 9) & 1) << 5); R = (st >> 1) * 16 + swz / 64; C = (st & 1) * 32 + (swz % 64) / 2; }
__host__ __device__ __forceinline__ int perm32(int rho) { const int n = rho >> 4, i = rho & 15; return 8 * (i >> 2) + 4 * n + (i & 3); }

struct Unit { int pm, pn; };
struct Gemm { const bf16_t* A; const bf16_t* Bt; int M, N, K; };

struct StaticOrder {
    int nM, nN, nwg, G, c;
    __host__ __device__ void init(int M, int N, int G_, int c_) { nM = M / BM; nN = N / BM; nwg = nM * nN; G = G_; c = c_; }
    __host__ __device__ bool next(int i, Unit& u) const {
        const long L = (long)i * G + c; if (L >= nwg) return false;
        int wgid = (int)L; { const int q = nwg / NXCD, r = nwg % NXCD, xcd = wgid % NXCD, off = wgid / NXCD; wgid = (xcd < r ? xcd * (q + 1) : r * (q + 1) + (xcd - r) * q) + off; }
        const int nig = WGM * nN, gid = wgid / nig, fm = gid * WGM, gsz = (nM - fm) < WGM ? (nM - fm) : WGM;
        u.pm = fm + ((wgid % nig) % gsz); u.pn = (wgid % nig) / gsz; return true;
    }
    __device__ __forceinline__ void a_ready(const Unit&) const {}
    __device__ __forceinline__ void done(const Unit&) const {}
};

__device__ __forceinline__ unsigned cvt_pk_bf16(float lo, float hi) { unsigned r; asm volatile("v_cvt_pk_bf16_f32 %0, %1, %2" : "=v"(r) : "v"(lo), "v"(hi)); return r; }
template <class Epi, class Sched, bool ALIGN_EPI = false, bool SP2 = false>
__device__ __forceinline__ void gemm_phase(PG8_LAS unsigned char* lds, const Gemm g, const Sched& S, const Epi& E) {
    const int tid = threadIdx.x, wid = __builtin_amdgcn_readfirstlane(tid >> 6), lane = tid & 63, wr = wid >> 2, wc = wid & 3, fr = lane & 15, fq = lane >> 4;
    const int K = g.K, nt = K / BK;
    unsigned voffA[2], voffB[2];
#pragma unroll
    for (int i = 0; i < 2; ++i) { int R, C; stage_rc(tid * 16 + i * 8192, R, C); const int Rb = Epi::PERM ? ((R & ~31) + perm32(R & 31)) : R;
        voffA[i] = (unsigned)(R * K + C) * 2u; voffB[i] = (unsigned)(Rb * K + C) * 2u; }
    const size_t kstep = (size_t)(BK * 2);
    const size_t hstep = (size_t)HALF * K * 2;
    const size_t tstep = 2 * hstep;
    const unsigned ldsw = (unsigned)wid * 1024u;
    const int aoff = lds_byte(wr * 64 + fr, fq * 8), boff = lds_byte(wc * 32 + fr, fq * 8);
#define PG8_SA(b, h) (((b) * 2 + (h)) * HTB)
#define PG8_SB(b, h) ((4 + (b) * 2 + (h)) * HTB)
#define PG8_STAGE(bufoff, gbase, voff) do { _Pragma("unroll") for (int _i = 0; _i < 2; ++_i) \
        __builtin_amdgcn_global_load_lds((const unsigned*)((const char*)(gbase) + (voff)[_i]), (PG8_LAS unsigned*)(lds + (bufoff) + ldsw + _i * 8192), 16, 0, 0); } while (0)
#define PG8_LDA(dst, b, h) do { _Pragma("unroll") for (int m = 0; m < 4; ++m) _Pragma("unroll") for (int k = 0; k < 2; ++k) dst[m][k] = *(const PG8_LAS bf16x8*)(lds + PG8_SA(b, h) + aoff + m * 2048 + k * 1024); } while (0)
#define PG8_LDB(dst, b, h) do { _Pragma("unroll") for (int n = 0; n < 2; ++n) _Pragma("unroll") for (int k = 0; k < 2; ++k) dst[n][k] = *(const PG8_LAS bf16x8*)(lds + PG8_SB(b, h) + boff + n * 2048 + k * 1024); } while (0)
#define PG8_MMA(ai, bj, At, Bt) do { __builtin_amdgcn_s_setprio(1); _Pragma("unroll") for (int m = 0; m < 4; ++m) _Pragma("unroll") for (int n = 0; n < 2; ++n) _Pragma("unroll") for (int k = 0; k < 2; ++k) \
        acc[ai][bj][m][n] = __builtin_amdgcn_mfma_f32_16x16x32_bf16(Bt[n][k], At[m][k], acc[ai][bj][m][n], 0, 0, 0); __builtin_amdgcn_s_setprio(0); } while (0)
#define PG8_WAIT_V(n) asm volatile("s_waitcnt vmcnt(" #n ")" ::: "memory")
#define PG8_WAIT_L(n) asm volatile("s_waitcnt lgkmcnt(" #n ")" ::: "memory")
#define PG8_BAR __builtin_amdgcn_s_barrier()
#define PG8_SCHED __builtin_amdgcn_sched_barrier(0)
    Unit cur, nxt; int ui = 0;
    if (!S.next(0, cur)) return;
    f32x4 acc[2][2][4][2];
#pragma unroll
    for (int a = 0; a < 2; ++a)
#pragma unroll
        for (int b = 0; b < 2; ++b)
#pragma unroll
            for (int m = 0; m < 4; ++m)
#pragma unroll
                for (int n = 0; n < 2; ++n) acc[a][b][m][n] = (f32x4){0.f, 0.f, 0.f, 0.f};
    bf16x8 At[4][2], B0[2][2], B1[2][2];
    const char* cA = (const char*)g.A + (size_t)cur.pm * tstep; const char* cB = (const char*)g.Bt + (size_t)cur.pn * tstep;
    S.a_ready(cur);
    if constexpr (SP2) {
        PG8_STAGE(PG8_SB(0, 0), cB, voffB); PG8_STAGE(PG8_SB(0, 1), cB + hstep, voffB); PG8_STAGE(PG8_SA(0, 0), cA, voffA); PG8_STAGE(PG8_SA(0, 1), cA + hstep, voffA);
        if (wr == 1) PG8_BAR;
        PG8_WAIT_V(2); PG8_BAR;
        PG8_STAGE(PG8_SB(1, 0), cB + kstep, voffB); PG8_STAGE(PG8_SA(1, 0), cA + kstep, voffA); PG8_STAGE(PG8_SB(1, 1), cB + hstep + kstep, voffB);
        PG8_WAIT_V(6); PG8_BAR;
    } else {
        PG8_STAGE(PG8_SB(0, 0), cB, voffB); PG8_STAGE(PG8_SA(0, 0), cA, voffA); PG8_STAGE(PG8_SB(0, 1), cB + hstep, voffB); PG8_STAGE(PG8_SA(0, 1), cA + hstep, voffA);
        if (wr == 1) PG8_BAR;
        PG8_WAIT_V(4); PG8_BAR;
        PG8_STAGE(PG8_SB(1, 0), cB + kstep, voffB); PG8_STAGE(PG8_SA(1, 0), cA + kstep, voffA); PG8_STAGE(PG8_SB(1, 1), cB + hstep + kstep, voffB);
        PG8_WAIT_V(6); PG8_BAR;
    }
    for (;;) {
        const bool has_next = S.next(ui + 1, nxt);
        const char* nA = has_next ? (const char*)g.A + (size_t)nxt.pm * tstep : cA; const char* nB = has_next ? (const char*)g.Bt + (size_t)nxt.pn * tstep : cB;
        for (int t = 0; t < nt; t += 2) {
            const bool last = (t == nt - 2);
            const char* a1 = cA + (size_t)(t + 1) * kstep;
            const char* a2 = last ? nA : cA + (size_t)(t + 2) * kstep; const char* b2 = last ? nB : cB + (size_t)(t + 2) * kstep;
            const char* a3 = a2 + kstep; const char* b3 = b2 + kstep;
            if (last && has_next) S.a_ready(nxt);
            if constexpr (SP2) {
            PG8_LDB(B0, 0, 0); PG8_LDB(B1, 0, 1); PG8_SCHED; PG8_LDA(At, 0, 0); PG8_STAGE(PG8_SA(1, 1), a1 + hstep, voffA);
            PG8_WAIT_V(8); PG8_WAIT_L(0); PG8_BAR; PG8_MMA(0, 0, At, B0); PG8_MMA(0, 1, At, B1); PG8_BAR; PG8_SCHED;
            PG8_LDA(At, 0, 1); PG8_STAGE(PG8_SB(0, 0), b2, voffB); PG8_STAGE(PG8_SB(0, 1), b2 + hstep, voffB); PG8_STAGE(PG8_SA(0, 0), a2, voffA);
            PG8_WAIT_V(8); PG8_WAIT_L(0); PG8_BAR; PG8_MMA(1, 0, At, B0); PG8_MMA(1, 1, At, B1); PG8_BAR; PG8_SCHED;
            PG8_LDB(B0, 1, 0); PG8_LDB(B1, 1, 1); PG8_SCHED; PG8_LDA(At, 1, 0); PG8_STAGE(PG8_SA(0, 1), a2 + hstep, voffA);
            PG8_WAIT_V(8); PG8_WAIT_L(0); PG8_BAR; PG8_MMA(0, 0, At, B0); PG8_MMA(0, 1, At, B1); PG8_BAR; PG8_SCHED;
            PG8_LDA(At, 1, 1); PG8_STAGE(PG8_SB(1, 0), b3, voffB); PG8_STAGE(PG8_SB(1, 1), b3 + hstep, voffB); PG8_STAGE(PG8_SA(1, 0), a3, voffA);
            PG8_WAIT_V(8); PG8_WAIT_L(0); PG8_BAR; PG8_MMA(1, 0, At, B0); PG8_MMA(1, 1, At, B1); PG8_BAR; PG8_SCHED;
            } else {
            PG8_LDB(B0, 0, 0); PG8_SCHED; PG8_LDA(At, 0, 0); PG8_STAGE(PG8_SA(1, 1), a1 + hstep, voffA);
            PG8_WAIT_L(8); PG8_BAR; PG8_WAIT_L(0); PG8_MMA(0, 0, At, B0); PG8_BAR; PG8_SCHED;
            PG8_LDB(B1, 0, 1); PG8_STAGE(PG8_SB(0, 0), b2, voffB);
            PG8_BAR; PG8_WAIT_L(0); PG8_MMA(0, 1, At, B1); PG8_BAR;
            PG8_LDA(At, 0, 1); PG8_STAGE(PG8_SA(0, 0), a2, voffA);
            PG8_BAR; PG8_WAIT_L(0); PG8_MMA(1, 0, At, B0); PG8_BAR; PG8_SCHED;
            PG8_STAGE(PG8_SB(0, 1), b2 + hstep, voffB);
            PG8_WAIT_V(6); PG8_BAR; PG8_MMA(1, 1, At, B1); PG8_BAR;
            PG8_LDB(B0, 1, 0); PG8_SCHED; PG8_LDA(At, 1, 0); PG8_STAGE(PG8_SA(0, 1), a2 + hstep, voffA);
            PG8_WAIT_L(8); PG8_BAR; PG8_WAIT_L(0); PG8_MMA(0, 0, At, B0); PG8_BAR; PG8_SCHED;
            PG8_LDB(B1, 1, 1); PG8_STAGE(PG8_SB(1, 0), b3, voffB);
            PG8_BAR; PG8_WAIT_L(0); PG8_MMA(0, 1, At, B1); PG8_BAR;
            PG8_LDA(At, 1, 1); PG8_STAGE(PG8_SA(1, 0), a3, voffA);
            PG8_BAR; PG8_WAIT_L(0); PG8_MMA(1, 0, At, B0); PG8_BAR; PG8_SCHED;
            PG8_STAGE(PG8_SB(1, 1), b3 + hstep, voffB);
            PG8_WAIT_V(6); PG8_BAR; PG8_MMA(1, 1, At, B1); PG8_BAR;
            }
        }
        if constexpr (ALIGN_EPI) { if (wr == 0) PG8_BAR; }
        if constexpr (!Epi::AFTER_DRAIN) { E(acc, cur, wr, wc, fr, fq); S.done(cur); }
        if (!has_next) break;
#pragma unroll
        for (int a = 0; a < 2; ++a)
#pragma unroll
            for (int b = 0; b < 2; ++b)
#pragma unroll
                for (int m = 0; m < 4; ++m)
#pragma unroll
                    for (int n = 0; n < 2; ++n) acc[a][b][m][n] = (f32x4){0.f, 0.f, 0.f, 0.f};
        cur = nxt; cA = nA; cB = nB; ++ui;
        if constexpr (ALIGN_EPI) { if (wr == 1) PG8_BAR; }
    }
    PG8_WAIT_V(0);
    if constexpr (!ALIGN_EPI) { if (wr == 0) PG8_BAR; }
    PG8_BAR;
    if constexpr (Epi::AFTER_DRAIN) { E.fused(acc, cur, wr, wc, fr, fq, lds, wid, lane); S.done(cur); }
#undef PG8_SA
#undef PG8_SB
#undef PG8_STAGE
#undef PG8_LDA
#undef PG8_LDB
#undef PG8_MMA
#undef PG8_WAIT_V
#undef PG8_WAIT_L
#undef PG8_BAR
#undef PG8_SCHED
}
}

using pg8::bf16_t; using pg8::bf16x8; using pg8::f32x4; using pg8::u32x4; using pg8::Unit;
#define LAS __attribute__((address_space(3)))
typedef unsigned u32x2 __attribute__((ext_vector_type(2)));
typedef float f32x2 __attribute__((ext_vector_type(2)));

constexpr int T_ = 16384, D_ = 1024, FF_ = 2816, RC_ = 1792, NTHR = 512, GWD_ = 512;
constexpr int LDS_BYTES = 163840;
constexpr int MS = 68;
constexpr int MBYTES = 64 * MS * 4;
constexpr int MISC_OFF = 9 * MBYTES;
constexpr int NCH = 256, NGRP = 32, GCH = 8;

constexpr size_t MiB = 1ull << 20;
constexpr size_t WS_HID = 0, WS_ZR = 0, WS_ZG = 56 * MiB, WS_PE = 0, WS_H4 = 32 * MiB;
constexpr size_t WS_ACTA = 88 * MiB, WS_ACTB = 120 * MiB;
constexpr size_t WS_W13A = 152 * MiB, WS_W2A = 163 * MiB, WS_WIN = 163 * MiB + 512 * 1024 * 11, WS_WOUT = 252 * MiB;
constexpr size_t WS_P = 120 * MiB, WS_Q = 152 * MiB, WS_Y0 = 184 * MiB, WS_RC = 200 * MiB, WS_G = 216 * MiB;
constexpr size_t WS_PC = 232 * MiB, WS_QC = 236 * MiB, WS_SG = 240 * MiB, WS_BON = 244 * MiB, WS_LNST = 245 * MiB;
constexpr size_t WS_SSQA = 246 * MiB, WS_SSQB = 247 * MiB;
constexpr size_t WS_W13B = 152 * MiB, WS_W2B = 163 * MiB, WS_WG = 163 * MiB + 512 * 1024 * 11, WS_WPLE = 171 * MiB, WS_PB = 172 * MiB;

typedef __bf16 bf16x2_t __attribute__((ext_vector_type(2)));
__device__ __forceinline__ unsigned pk2(float lo, float hi) { const f32x2 v = {lo, hi}; const bf16x2_t b = __builtin_convertvector(v, bf16x2_t); return __builtin_bit_cast(unsigned, b); }
__device__ __forceinline__ float bf2f(bf16_t b) { return __uint_as_float(((unsigned)b) << 16); }
__device__ __forceinline__ bf16_t f2bf(float f) { return (bf16_t)(pk2(f, 0.f) & 0xffffu); }
__device__ __forceinline__ float dpp_f(float v, const int ctrl_sel) {
    int i = __float_as_int(v), r;
    if (ctrl_sel == 0) r = __builtin_amdgcn_update_dpp(i, i, 0xB1, 0xF, 0xF, false);
    else if (ctrl_sel == 1) r = __builtin_amdgcn_update_dpp(i, i, 0x4E, 0xF, 0xF, false);
    else if (ctrl_sel == 2) r = __builtin_amdgcn_update_dpp(i, i, 0x141, 0xF, 0xF, false);
    else r = __builtin_amdgcn_update_dpp(i, i, 0x140, 0xF, 0xF, false);
    return __int_as_float(r);
}
__device__ __forceinline__ float wave_sum(float v) {
    v += dpp_f(v, 0); v += dpp_f(v, 1); v += dpp_f(v, 2); v += dpp_f(v, 3);
    const int vi = __float_as_int(v);
    const float s0 = __int_as_float(__builtin_amdgcn_readlane(vi, 0)), s1 = __int_as_float(__builtin_amdgcn_readlane(vi, 16)), s2 = __int_as_float(__builtin_amdgcn_readlane(vi, 32)), s3 = __int_as_float(__builtin_amdgcn_readlane(vi, 48));
    return (s0 + s1) + (s2 + s3);
}
__device__ __forceinline__ float row_rstd(const float* ssq, int row) {
    const f32x4* p = (const f32x4*)(ssq + (size_t)row * 16);
    const f32x4 a = p[0], b = p[1], c = p[2], d = p[3];
    const float s = (((a[0] + a[1]) + (a[2] + a[3])) + ((b[0] + b[1]) + (b[2] + b[3]))) + (((c[0] + c[1]) + (c[2] + c[3])) + ((d[0] + d[1]) + (d[2] + d[3])));
    return 1.0f / sqrtf(s * (1.0f / 1024.0f) + 1e-6f);
}
__device__ __forceinline__ float row_rstd_q(const float* ssq, int row, int fq) {
    const f32x4 a = ((const f32x4*)(ssq + (size_t)row * 16))[fq];
    float s = (a[0] + a[1]) + (a[2] + a[3]);
    s += __shfl_xor(s, 16); s += __shfl_xor(s, 32);
    return 1.0f / sqrtf(s * (1.0f / 1024.0f) + 1e-6f);
}
__device__ __forceinline__ float frcp(float x) { return __builtin_amdgcn_rcpf(x); }
__device__ __forceinline__ float gelu_erf(float v) {
    const float av = fabsf(v), t = frcp(av * 0.2316418882f + 1.0f);
    float qq = t * 0.5307027145f + (-0.7265760135f); qq = qq * t + 0.7107068705f; qq = qq * t + (-0.142248368f); qq = qq * t + 0.127414796f; qq = qq * t;
    const float e = __builtin_amdgcn_exp2f((v * v) * (-0.72134752044f));
    const float m = v * (qq * e);
    return v < 0.f ? m : v - m;
}
__device__ __forceinline__ float sigmoidf_(float x) { return frcp(1.0f + __expf(-x)); }
__device__ __forceinline__ float tanhf_(float x) { return 1.0f - 2.0f * frcp(1.0f + __expf(2.0f * x)); }

struct EpiSwiGLU {
    static constexpr bool PERM = true, AFTER_DRAIN = false;
    bf16_t* O; const float* ssq;
    __device__ __forceinline__ void operator()(const f32x4 (&acc)[2][2][4][2], const Unit& u, int wr, int wc, int fr, int fq) const {
        const int row0 = u.pm * 256 + wr * 64 + fr, col0 = u.pn * 128 + wc * 32 + 8 * fq;
#pragma unroll
        for (int ai = 0; ai < 2; ++ai)
#pragma unroll
            for (int m = 0; m < 4; ++m) {
                const int row = row0 + ai * 128 + m * 16; const float rs = row_rstd_q(ssq, row, fq);
                float h[8];
#pragma unroll
                for (int n = 0; n < 2; ++n) {
                    const f32x4 a = acc[ai][0][m][n] * rs, b = acc[ai][1][m][n] * rs;
#pragma unroll
                    for (int j = 0; j < 4; ++j) h[4 * n + j] = a[j] * frcp(1.0f + __expf(-a[j])) * b[j];
                }
                u32x4 w; w.x = pk2(h[0], h[1]); w.y = pk2(h[2], h[3]); w.z = pk2(h[4], h[5]); w.w = pk2(h[6], h[7]);
                *(u32x4*)(O + (size_t)row * FF_ + col0) = w;
            }
    }
};
__device__ __forceinline__ f32x4 bflo4(unsigned a, unsigned b) { return (f32x4){__uint_as_float(a << 16), __uint_as_float(a & 0xffff0000u), __uint_as_float(b << 16), __uint_as_float(b & 0xffff0000u)}; }
template <int MODE, bool RLO, bool WLO> struct EpiResid {
    static constexpr bool PERM = true, AFTER_DRAIN = false;
    const float* basef; const bf16_t* bhi; const bf16_t* lo; bf16_t* olo; bf16_t* ohi; float* ssq; float scale;
    __device__ __forceinline__ void operator()(const f32x4 (&acc)[2][2][4][2], const Unit& u, int wr, int wc, int fr, int fq) const {
        const int row0 = u.pm * 256 + wr * 64 + fr, col0 = u.pn * 256 + wc * 32 + 8 * fq;
#pragma unroll
        for (int ai = 0; ai < 2; ++ai)
#pragma unroll
            for (int m = 0; m < 4; ++m) {
                const int row = row0 + ai * 128 + m * 16; float ss = 0.f;
#pragma unroll
                for (int bj = 0; bj < 2; ++bj) {
                    const size_t off = (size_t)row * D_ + col0 + bj * 128;
                    f32x4 b0, b1;
                    if (MODE == 0) { b0 = *(const f32x4*)(basef + off); b1 = *(const f32x4*)(basef + off + 4); }
                    else { const u32x4 h = *(const u32x4*)(bhi + off); b0 = bflo4(h.x, h.y); b1 = bflo4(h.z, h.w);
                           if (RLO) { const u32x4 l = *(const u32x4*)(lo + off); b0 = b0 + bflo4(l.x, l.y); b1 = b1 + bflo4(l.z, l.w); } }
                    const f32x4 v0 = b0 + acc[ai][bj][m][0] * scale, v1 = b1 + acc[ai][bj][m][1] * scale;
                    u32x4 w; w.x = pk2(v0[0], v0[1]); w.y = pk2(v0[2], v0[3]); w.z = pk2(v1[0], v1[1]); w.w = pk2(v1[2], v1[3]);
                    const f32x4 r0 = v0 - bflo4(w.x, w.y), r1 = v1 - bflo4(w.z, w.w);
                    u32x4 wl; wl.x = pk2(r0[0], r0[1]); wl.y = pk2(r0[2], r0[3]); wl.z = pk2(r1[0], r1[1]); wl.w = pk2(r1[2], r1[3]);
                    *(u32x4*)(ohi + off) = w; if (WLO) *(u32x4*)(olo + off) = wl;
                    ss += ((v0[0] * v0[0] + v0[1] * v0[1]) + (v0[2] * v0[2] + v0[3] * v0[3])) + ((v1[0] * v1[0] + v1[1] * v1[1]) + (v1[2] * v1[2] + v1[3] * v1[3]));
                }
                ss += __shfl_xor(ss, 16); ss += __shfl_xor(ss, 32);
                if (fq == 0) ssq[(size_t)row * 16 + u.pn * 4 + wc] = ss;
            }
    }
};
struct EpiZ {
    static constexpr bool PERM = true, AFTER_DRAIN = false;
    bf16_t* zr; bf16_t* zg; const float* ssq; float* lnst;
    __device__ __forceinline__ void operator()(const f32x4 (&acc)[2][2][4][2], const Unit& u, int wr, int wc, int fr, int fq) const {
        const int row0 = u.pm * 256 + wr * 64 + fr; const bool isg = u.pn >= 7;
        const int col0 = (isg ? (u.pn - 7) * 256 : u.pn * 256) + wc * 32 + 8 * fq;
        bf16_t* basep = isg ? zg : zr; const int ld = isg ? 1024 : RC_;
#pragma unroll
        for (int ai = 0; ai < 2; ++ai)
#pragma unroll
            for (int m = 0; m < 4; ++m) {
                const int row = row0 + ai * 128 + m * 16; const float rs = row_rstd_q(ssq, row, fq); float s1 = 0.f, s2 = 0.f;
#pragma unroll
                for (int bj = 0; bj < 2; ++bj) {
                    f32x4 v0 = acc[ai][bj][m][0] * rs, v1 = acc[ai][bj][m][1] * rs;
                    if (isg) {
#pragma unroll
                        for (int j = 0; j < 4; ++j) { v0[j] = gelu_erf(v0[j]); v1[j] = gelu_erf(v1[j]); }
                        s1 += ((v0[0] + v0[1]) + (v0[2] + v0[3])) + ((v1[0] + v1[1]) + (v1[2] + v1[3]));
                        s2 += ((v0[0] * v0[0] + v0[1] * v0[1]) + (v0[2] * v0[2] + v0[3] * v0[3])) + ((v1[0] * v1[0] + v1[1] * v1[1]) + (v1[2] * v1[2] + v1[3] * v1[3]));
                    }
                    u32x4 w; w.x = pk2(v0[0], v0[1]); w.y = pk2(v0[2], v0[3]); w.z = pk2(v1[0], v1[1]); w.w = pk2(v1[2], v1[3]);
                    *(u32x4*)(basep + (size_t)row * ld + col0 + bj * 128) = w;
                }
                if (u.pn >= 9) {
                    s1 += __shfl_xor(s1, 16); s1 += __shfl_xor(s1, 32); s2 += __shfl_xor(s2, 16); s2 += __shfl_xor(s2, 32);
                    if (fq == 0) { f32x2 o; o.x = s1; o.y = s2; *(f32x2*)(lnst + (size_t)row * 16 + ((u.pn - 9) * 4 + wc) * 2) = o; }
                }
            }
    }
};
struct EpiPE {
    static constexpr bool PERM = true, AFTER_DRAIN = false;
    bf16_t* pe;
    __device__ __forceinline__ void operator()(const f32x4 (&acc)[2][2][4][2], const Unit& u, int wr, int wc, int fr, int fq) const {
        const int row0 = u.pm * 256 + wr * 64 + fr, col0 = u.pn * 256 + wc * 32 + 8 * fq;
#pragma unroll
        for (int ai = 0; ai < 2; ++ai)
#pragma unroll
            for (int m = 0; m < 4; ++m)
#pragma unroll
                for (int bj = 0; bj < 2; ++bj) {
                    const size_t off = (size_t)(row0 + ai * 128 + m * 16) * D_ + col0 + bj * 128;
                    const f32x4 v0 = acc[ai][bj][m][0], v1 = acc[ai][bj][m][1];
                    u32x4 w; w.x = pk2(v0[0], v0[1]); w.y = pk2(v0[2], v0[3]); w.z = pk2(v1[0], v1[1]); w.w = pk2(v1[2], v1[3]);
                    *(u32x4*)(pe + off) = w;
                }
    }
};
struct EpiGate {
    static constexpr bool PERM = true, AFTER_DRAIN = false;
    const bf16_t* pe; const bf16_t* h3hi; const bf16_t* h3lo; bf16_t* h4; const float* ssq_in; float* ssq;
    __device__ __forceinline__ void operator()(const f32x4 (&acc)[2][2][4][2], const Unit& u, int wr, int wc, int fr, int fq) const {
        const int row0 = u.pm * 256 + wr * 64 + fr, col0 = u.pn * 256 + wc * 32 + 8 * fq;
#pragma unroll
        for (int ai = 0; ai < 2; ++ai)
#pragma unroll
            for (int m = 0; m < 4; ++m) {
                const int row = row0 + ai * 128 + m * 16; const float rs = row_rstd_q(ssq_in, row, fq); float ss = 0.f;
#pragma unroll
                for (int bj = 0; bj < 2; ++bj) {
                    const size_t off = (size_t)row * D_ + col0 + bj * 128;
                    const u32x4 hh = *(const u32x4*)(h3hi + off);
                    f32x4 b0 = bflo4(hh.x, hh.y), b1 = bflo4(hh.z, hh.w);
                    if (h3lo) { const u32x4 hl = *(const u32x4*)(h3lo + off); b0 = b0 + bflo4(hl.x, hl.y); b1 = b1 + bflo4(hl.z, hl.w); }
                    const u32x4 pw = *(const u32x4*)(pe + off);
                    const f32x4 p0 = (f32x4){__uint_as_float(pw.x << 16), __uint_as_float(pw.x & 0xffff0000u), __uint_as_float(pw.y << 16), __uint_as_float(pw.y & 0xffff0000u)};
                    const f32x4 p1 = (f32x4){__uint_as_float(pw.z << 16), __uint_as_float(pw.z & 0xffff0000u), __uint_as_float(pw.w << 16), __uint_as_float(pw.w & 0xffff0000u)};
                    f32x4 v0, v1;
#pragma unroll
                    for (int j = 0; j < 4; ++j) { v0[j] = b0[j] + sigmoidf_(acc[ai][bj][m][0][j] * rs) * p0[j]; v1[j] = b1[j] + sigmoidf_(acc[ai][bj][m][1][j] * rs) * p1[j]; }
                    u32x4 w; w.x = pk2(v0[0], v0[1]); w.y = pk2(v0[2], v0[3]); w.z = pk2(v1[0], v1[1]); w.w = pk2(v1[2], v1[3]);
                    *(u32x4*)(h4 + off) = w;
                    ss += ((v0[0] * v0[0] + v0[1] * v0[1]) + (v0[2] * v0[2] + v0[3] * v0[3])) + ((v1[0] * v1[0] + v1[1] * v1[1]) + (v1[2] * v1[2] + v1[3] * v1[3]));
                }
                ss += __shfl_xor(ss, 16); ss += __shfl_xor(ss, 32);
                if (fq == 0) ssq[(size_t)row * 16 + u.pn * 4 + wc] = ss;
            }
    }
};

struct EpiGateFinal {
    static constexpr bool PERM = true, AFTER_DRAIN = true;
    const bf16_t* pe; const bf16_t* h3hi; const bf16_t* h3lo  ; float* out; const float* gfin; const float* ssq_in; float* ssq; unsigned* cnt;
    __device__ __forceinline__ void operator()(const f32x4 (&)[2][2][4][2], const Unit&, int, int, int, int) const {}
    __device__ __forceinline__ void fused(const f32x4 (&acc_)[2][2][4][2], const Unit& u, int wr, int wc, int fr, int fq, LAS unsigned char*, int, int) const {
        f32x4 (&acc)[2][2][4][2] = const_cast<f32x4 (&)[2][2][4][2]>(acc_);
        const int row0 = u.pm * 256 + wr * 64 + fr, col0 = u.pn * 256 + wc * 32 + 8 * fq;
#pragma unroll
        for (int ai = 0; ai < 2; ++ai)
#pragma unroll
            for (int m = 0; m < 4; ++m) {
                const int row = row0 + ai * 128 + m * 16; const float rs = row_rstd_q(ssq_in, row, fq); float ss = 0.f;
#pragma unroll
                for (int bj = 0; bj < 2; ++bj) {
                    const size_t off = (size_t)row * D_ + col0 + bj * 128;
                    const u32x4 hh = *(const u32x4*)(h3hi + off);
                    f32x4 b0 = bflo4(hh.x, hh.y), b1 = bflo4(hh.z, hh.w);
                    if (h3lo) { const u32x4 hl = *(const u32x4*)(h3lo + off); b0 = b0 + bflo4(hl.x, hl.y); b1 = b1 + bflo4(hl.z, hl.w); }
                    const u32x4 pw = *(const u32x4*)(pe + off);
                    const f32x4 p0 = bflo4(pw.x, pw.y), p1 = bflo4(pw.z, pw.w);
                    f32x4 v0, v1;
#pragma unroll
                    for (int j = 0; j < 4; ++j) { v0[j] = b0[j] + sigmoidf_(acc[ai][bj][m][0][j] * rs) * p0[j]; v1[j] = b1[j] + sigmoidf_(acc[ai][bj][m][1][j] * rs) * p1[j]; }
                    acc[ai][bj][m][0] = v0; acc[ai][bj][m][1] = v1;
                    ss += ((v0[0] * v0[0] + v0[1] * v0[1]) + (v0[2] * v0[2] + v0[3] * v0[3])) + ((v1[0] * v1[0] + v1[1] * v1[1]) + (v1[2] * v1[2] + v1[3] * v1[3]));
                }
                ss += __shfl_xor(ss, 16); ss += __shfl_xor(ss, 32);
                if (fq == 0) ssq[(size_t)row * 16 + u.pn * 4 + wc] = ss;
            }
        asm volatile("s_waitcnt vmcnt(0)" ::: "memory");
        __syncthreads();
        if (threadIdx.x == 0) {
            __builtin_amdgcn_fence(__ATOMIC_RELEASE, "agent");
            asm volatile("s_waitcnt vmcnt(0)" ::: "memory");
            unsigned* c = cnt + 64 * u.pm;
            (void)__hip_atomic_fetch_add(c, 1u, __ATOMIC_RELAXED, __HIP_MEMORY_SCOPE_AGENT);
            unsigned sp = 0;
            while (__hip_atomic_load(c, __ATOMIC_RELAXED, __HIP_MEMORY_SCOPE_AGENT) < 4u) { __builtin_amdgcn_s_sleep(1); if (++sp > (1u << 22)) break; }
            __builtin_amdgcn_fence(__ATOMIC_ACQUIRE, "agent");
            asm volatile("s_waitcnt vmcnt(0)" ::: "memory");
        }
        __syncthreads();
        f32x4 g0[2], g1[2];
#pragma unroll
        for (int bj = 0; bj < 2; ++bj) { g0[bj] = *(const f32x4*)(gfin + col0 + bj * 128); g1[bj] = *(const f32x4*)(gfin + col0 + bj * 128 + 4); }
#pragma unroll
        for (int ai = 0; ai < 2; ++ai)
#pragma unroll
            for (int m = 0; m < 4; ++m) {
                const int row = row0 + ai * 128 + m * 16; const float rs = row_rstd_q(ssq, row, fq);
#pragma unroll
                for (int bj = 0; bj < 2; ++bj) {
                    const size_t off = (size_t)row * D_ + col0 + bj * 128;
                    *(f32x4*)(out + off) = acc[ai][bj][m][0] * rs * g0[bj]; *(f32x4*)(out + off + 4) = acc[ai][bj][m][1] * rs * g1[bj];
                }
            }
    }
};

__device__ __forceinline__ int map13(int hidden, int which) { return (hidden >> 7) * 256 + which * 128 + (hidden & 127); }
__device__ __forceinline__ void transpose_item(const float* W, int K, int N, const float* gain, bf16_t* WT, int mode, LAS float* scr, int item, int lane) {
    const int nblk = N / 32, kb = item / nblk, nb = item % nblk, k0 = 64 * kb, n0 = 32 * nb;
#pragma unroll
    for (int i = 0; i < 32; ++i) { const int kk = 2 * i + (lane >> 5); float w = W[(size_t)(k0 + kk) * N + n0 + (lane & 31)]; if (gain) w *= gain[k0 + kk]; scr[kk * 33 + (lane & 31)] = w; }
    asm volatile("s_waitcnt lgkmcnt(0)" ::: "memory");
    const int c = lane & 7;
#pragma unroll
    for (int j = 0; j < 4; ++j) { const int n = (lane >> 3) + 8 * j; const LAS float* s = scr + (8 * c) * 33 + n;
        u32x4 o; o.x = pk2(s[0 * 33], s[1 * 33]); o.y = pk2(s[2 * 33], s[3 * 33]); o.z = pk2(s[4 * 33], s[5 * 33]); o.w = pk2(s[6 * 33], s[7 * 33]);
        const int row = (mode == 0) ? (n0 + n) : map13(n0 + n, mode - 1);
        *(u32x4*)(WT + (size_t)row * K + k0 + 8 * c) = o; }
    asm volatile("s_waitcnt lgkmcnt(0)" ::: "memory");
}

template <class FA, class FB>
__device__ __forceinline__ void mm_acc(f32x4 (&acc)[2], int K, int mrow, int nc0, int q, FA fa, FB fb) {
#pragma unroll 4
    for (int k0 = 0; k0 < K; k0 += 4) {
        const float a = fa(mrow, k0 + q), b0 = fb(k0 + q, nc0), b1 = fb(k0 + q, nc0 + 16);
        acc[0] = __builtin_amdgcn_mfma_f32_16x16x4f32(a, b0, acc[0], 0, 0, 0);
        acc[1] = __builtin_amdgcn_mfma_f32_16x16x4f32(a, b1, acc[1], 0, 0, 0);
    }
}
#define ZACC(a) do { a[0] = (f32x4){0.f, 0.f, 0.f, 0.f}; a[1] = (f32x4){0.f, 0.f, 0.f, 0.f}; } while (0)

struct Ctx {
    LAS unsigned char* lds; int tid, lane, wave, G, bid;
    const float* const* in; float* out; unsigned char* ws;
};
#define MAT(i) ((LAS float*)(C.lds + (i) * MBYTES))

__device__ __forceinline__ float zshift(const bf16_t* zr, int tok, int col, float mu) {
    const float cur = bf2f(zr[(size_t)tok * RC_ + col]);
    const float prv = bf2f(zr[(size_t)(tok > 0 ? tok - 1 : 0) * RC_ + col]) * (tok > 0 ? 1.f : 0.f);
    return cur + (prv - cur) * mu;
}

constexpr int BS = 72;
constexpr int BBYTES = 64 * BS * 2;
constexpr int F_OFF = 0, B_OFF = 3 * MBYTES;
constexpr int AMISC_OFF = B_OFF + 11 * BBYTES;
constexpr size_t WS_LORA = 254 * MiB;
#define FM(i) ((LAS float*)(C.lds + F_OFF + (i) * MBYTES))
#define BM_(i) ((LAS bf16_t*)(C.lds + B_OFF + (i) * BBYTES))
__device__ __forceinline__ void mmb(f32x4 (&acc)[2], const LAS bf16_t* A, const LAS bf16_t* B, int mrow, int nc0, int q) {
#pragma unroll
    for (int ks = 0; ks < 2; ++ks) {
        const bf16x8 a = *(const LAS bf16x8*)(A + mrow * BS + ks * 32 + q * 8);
        const bf16x8 b0 = *(const LAS bf16x8*)(B + nc0 * BS + ks * 32 + q * 8), b1 = *(const LAS bf16x8*)(B + (nc0 + 16) * BS + ks * 32 + q * 8);
        acc[0] = __builtin_amdgcn_mfma_f32_16x16x32_bf16(a, b0, acc[0], 0, 0, 0);
        acc[1] = __builtin_amdgcn_mfma_f32_16x16x32_bf16(a, b1, acc[1], 0, 0, 0);
    }
}
__device__ __forceinline__ void mmb_g(f32x4 (&acc)[2], const LAS bf16_t* A, const bf16_t* Bg, int ldb, int mrow, int nrow0, int q) {
#pragma unroll
    for (int ks = 0; ks < 2; ++ks) {
        const bf16x8 a = *(const LAS bf16x8*)(A + mrow * BS + ks * 32 + q * 8);
        const bf16x8 b0 = *(const bf16x8*)(Bg + (size_t)nrow0 * ldb + ks * 32 + q * 8), b1 = *(const bf16x8*)(Bg + (size_t)(nrow0 + 16) * ldb + ks * 32 + q * 8);
        acc[0] = __builtin_amdgcn_mfma_f32_16x16x32_bf16(a, b0, acc[0], 0, 0, 0);
        acc[1] = __builtin_amdgcn_mfma_f32_16x16x32_bf16(a, b1, acc[1], 0, 0, 0);
    }
}
__device__ __forceinline__ void mmb_gg(f32x4 (&acc)[2], const bf16_t* Ag, int lda, const bf16_t* Bg, int ldb, int mrow, int nrow0, int q) {
#pragma unroll
    for (int ks = 0; ks < 2; ++ks) {
        const bf16x8 a = *(const bf16x8*)(Ag + (size_t)mrow * lda + ks * 32 + q * 8);
        const bf16x8 b0 = *(const bf16x8*)(Bg + (size_t)nrow0 * ldb + ks * 32 + q * 8), b1 = *(const bf16x8*)(Bg + (size_t)(nrow0 + 16) * ldb + ks * 32 + q * 8);
        acc[0] = __builtin_amdgcn_mfma_f32_16x16x32_bf16(a, b0, acc[0], 0, 0, 0);
        acc[1] = __builtin_amdgcn_mfma_f32_16x16x32_bf16(a, b1, acc[1], 0, 0, 0);
    }
}
__device__ __forceinline__ void zload9(const bf16_t* zr, int tok, int col, bf16_t (&raw)[9]) {
    raw[0] = zr[(size_t)(tok > 0 ? tok - 1 : 0) * RC_ + col];
#pragma unroll
    for (int u = 0; u < 8; ++u) raw[u + 1] = zr[(size_t)(tok + u) * RC_ + col];
}
__device__ __forceinline__ void zmix8(const bf16_t (&raw)[9], float pz, float mu, float (&o)[8]) {
    float prv = bf2f(raw[0]) * pz;
#pragma unroll
    for (int u = 0; u < 8; ++u) { const float cur = bf2f(raw[u + 1]); o[u] = cur + (prv - cur) * mu; prv = cur; }
}
__device__ __forceinline__ u32x4 pack8(const float (&v)[8]) { u32x4 w; w.x = pk2(v[0], v[1]); w.y = pk2(v[2], v[3]); w.z = pk2(v[4], v[5]); w.w = pk2(v[6], v[7]); return w; }

__device__ __forceinline__ void rwkv_phase_a(const Ctx& C) {
    const bf16_t* zr = (const bf16_t*)(C.ws + WS_ZR);
    const float* mu = C.in[8]; const float* w0 = C.in[9]; const float* a0 = C.in[11];
    const float* k_k = C.in[14]; const float* k_a = C.in[15]; const float* r_k = C.in[16];
    const bf16_t* wdecT = (const bf16_t*)(C.ws + WS_LORA); const bf16_t* waaaT = wdecT + 512 * 64; const bf16_t* wgateT = waaaT + 512 * 64;
    float* Pg = (float*)(C.ws + WS_P); float* Qg = (float*)(C.ws + WS_Q); bf16_t* Y0g = (bf16_t*)(C.ws + WS_Y0); bf16_t* Rcg = (bf16_t*)(C.ws + WS_RC);
    bf16_t* Gg = (bf16_t*)(C.ws + WS_G); float* bon = (float*)(C.ws + WS_BON);
    LAS float* misc = (LAS float*)(C.lds + AMISC_OFF);
    LAS float* DI = (LAS float*)BM_(10);
    const int w = C.wave;
    const int mt = w >> 1, nt0 = (w & 1) * 2;

    bf16_t* scrg = (bf16_t*)(C.ws + WS_PC) + (size_t)C.bid * (64 * 256);
    for (int c = C.bid; c < NCH; c += C.G) {
      const int tok0 = c * 64;
      {
          int tid = C.tid; asm volatile("" : "+v"(tid));
          const int ci = tid & 63, tg8 = tid >> 6, tokb = tok0 + tg8 * 8;
          bf16_t r0[9], r1[9], r2[9], r3[9];
          zload9(zr, tokb, 1536 + ci, r0); zload9(zr, tokb, 1600 + ci, r1); zload9(zr, tokb, 1664 + ci, r2); zload9(zr, tokb, 1728 + ci, r3);
          const float m0 = mu[1536 + ci], m1 = mu[1600 + ci], m2 = mu[1664 + ci], m3 = mu[1728 + ci];
          const float pz = tokb > 0 ? 1.f : 0.f;
          float t8[8];
          zmix8(r0, pz, m0, t8);
#pragma unroll
          for (int u = 0; u < 8; ++u) scrg[(tg8 * 8 + u) * 256 + ci] = f2bf(tanhf_(t8[u]));
          zmix8(r1, pz, m1, t8);
#pragma unroll
          for (int u = 0; u < 8; ++u) scrg[(tg8 * 8 + u) * 256 + 64 + ci] = f2bf(t8[u]);
          zmix8(r2, pz, m2, t8);
#pragma unroll
          for (int u = 0; u < 8; ++u) scrg[(tg8 * 8 + u) * 256 + 128 + ci] = f2bf(sigmoidf_(t8[u]));
          zmix8(r3, pz, m3, t8);
#pragma unroll
          for (int u = 0; u < 8; ++u) scrg[(tg8 * 8 + u) * 256 + 192 + ci] = f2bf(sigmoidf_(t8[u]));
          asm volatile("s_waitcnt vmcnt(0)" ::: "memory");
          __syncthreads();
          __builtin_amdgcn_fence(__ATOMIC_ACQUIRE, "agent");
          asm volatile("s_waitcnt vmcnt(0)" ::: "memory");
      }
      bf16x8 Af[4][2], Bf[4][2][2]; bf16_t zn[3][9];
      {
          int tid = C.tid; asm volatile("" : "+v"(tid));
          const int lane = tid & 63, q = lane >> 4, l15 = lane & 15, mrow = mt * 16 + l15, nc0 = nt0 * 16 + l15, ci = tid & 63, tokb = tok0 + (tid >> 6) * 8;
#pragma unroll
          for (int g = 0; g < 4; ++g)
#pragma unroll
              for (int ks = 0; ks < 2; ++ks) Af[g][ks] = *(const bf16x8*)(scrg + (size_t)mrow * 256 + g * 64 + ks * 32 + q * 8);
#pragma unroll
          for (int ks = 0; ks < 2; ++ks)
#pragma unroll
              for (int i = 0; i < 2; ++i) { const int row = nc0 + 16 * i;
                  Bf[0][ks][i] = *(const bf16x8*)(wdecT + (size_t)row * 64 + ks * 32 + q * 8); Bf[1][ks][i] = *(const bf16x8*)(waaaT + (size_t)row * 64 + ks * 32 + q * 8);
                  Bf[2][ks][i] = *(const bf16x8*)(wgateT + (size_t)row * 128 + ks * 32 + q * 8); Bf[3][ks][i] = *(const bf16x8*)(wgateT + (size_t)row * 128 + 64 + ks * 32 + q * 8); }
          zload9(zr, tokb, ci, zn[0]); zload9(zr, tokb, 512 + ci, zn[1]); zload9(zr, tokb, 1024 + ci, zn[2]);
      }
      for (int h = 0; h < 8; ++h) {
        const int item = c * 8 + h;
        int tid = C.tid; asm volatile("" : "+v"(tid));
        const int lane = tid & 63, q = lane >> 4, l15 = lane & 15;
        const int mrow = mt * 16 + l15, nc0 = nt0 * 16 + l15;
        const int ci = tid & 63, tg8 = tid >> 6;
        const int tokb = tok0 + tg8 * 8;
        float rr[8], kx[8], vx[8];
        {
            const float m4 = mu[h * 64 + ci], m5 = mu[512 + h * 64 + ci], m6 = mu[1024 + h * 64 + ci];
            const float pz = tokb > 0 ? 1.f : 0.f;
            zmix8(zn[0], pz, m4, rr); zmix8(zn[1], pz, m5, kx); zmix8(zn[2], pz, m6, vx);
        }
        {
            f32x4 aw[2], aa[2], ag[2]; ZACC(aw); ZACC(aa); ZACC(ag);
#pragma unroll
            for (int ks = 0; ks < 2; ++ks)
#pragma unroll
                for (int i = 0; i < 2; ++i) {
                    aw[i] = __builtin_amdgcn_mfma_f32_16x16x32_bf16(Af[0][ks], Bf[0][ks][i], aw[i], 0, 0, 0);
                    aa[i] = __builtin_amdgcn_mfma_f32_16x16x32_bf16(Af[1][ks], Bf[1][ks][i], aa[i], 0, 0, 0);
                    ag[i] = __builtin_amdgcn_mfma_f32_16x16x32_bf16(Af[2][ks], Bf[2][ks][i], ag[i], 0, 0, 0);
                    ag[i] = __builtin_amdgcn_mfma_f32_16x16x32_bf16(Af[3][ks], Bf[3][ks][i], ag[i], 0, 0, 0);
                }
            if (h + 1 < 8) {
                const int hn = h + 1;
#pragma unroll
                for (int ks = 0; ks < 2; ++ks)
#pragma unroll
                    for (int i = 0; i < 2; ++i) { const int row = hn * 64 + nc0 + 16 * i;
                        Bf[0][ks][i] = *(const bf16x8*)(wdecT + (size_t)row * 64 + ks * 32 + q * 8); Bf[1][ks][i] = *(const bf16x8*)(waaaT + (size_t)row * 64 + ks * 32 + q * 8);
                        Bf[2][ks][i] = *(const bf16x8*)(wgateT + (size_t)row * 128 + ks * 32 + q * 8); Bf[3][ks][i] = *(const bf16x8*)(wgateT + (size_t)row * 128 + 64 + ks * 32 + q * 8); }
                zload9(zr, tokb, hn * 64 + ci, zn[0]); zload9(zr, tokb, 512 + hn * 64 + ci, zn[1]); zload9(zr, tokb, 1024 + hn * 64 + ci, zn[2]);
            }
#pragma unroll
            for (int i = 0; i < 2; ++i) {
                const int ch = nc0 + 16 * i; const float w0c = w0[h * 64 + ch], a0c = a0[h * 64 + ch];
#pragma unroll
                for (int j = 0; j < 4; ++j) {
                    const int t = mt * 16 + 4 * q + j;
                    FM(0)[t * MS + ch] = -0.60653065971f * sigmoidf_(w0c + aw[i][j]);
                    FM(1)[t * MS + ch] = sigmoidf_(a0c + aa[i][j]);
                    Gg[(size_t)(tok0 + t) * GWD_ + h * 64 + ch] = f2bf(ag[i][j]);
                }
            }
        }
        __syncthreads();
        {
            float ld[8], av[8], kkv[8], k2[8], cl[8];
            const float kkc = k_k[h * 64 + ci], kac = k_a[h * 64 + ci], rkc = r_k[h * 64 + ci];
            float run = 0.f;
#pragma unroll
            for (int u = 0; u < 8; ++u) {
                const int t = tg8 * 8 + u;
                ld[u] = FM(0)[t * MS + ci]; av[u] = FM(1)[t * MS + ci];
                const float kr = kx[u] * kkc; const float n2 = wave_sum(kr * kr);
                kkv[u] = kr * __builtin_amdgcn_rsqf(fmaxf(n2, 1e-24f));
                k2[u] = kx[u] * (1.0f + (av[u] - 1.0f) * kac);
                const float bs = wave_sum(rr[u] * k2[u] * rkc);
                if (lane == 0) bon[(size_t)(tok0 + t) * 8 + h] = bs;
                run += ld[u]; cl[u] = run;
            }
            misc[64 + tg8 * 64 + ci] = run;
            __syncthreads();
            float pre = 0.f, tot = 0.f;
#pragma unroll
            for (int g = 0; g < 8; ++g) { const float v = misc[64 + g * 64 + ci]; tot += v; if (g < tg8) pre += v; }
            if (tg8 == 0) misc[ci] = __expf(tot);
            float bh[8], kh[8];
#pragma unroll
            for (int u = 0; u < 8; ++u) {
                const int t = tg8 * 8 + u; const float cu = cl[u] + pre, cp = cu - ld[u];
                const float e_m = __expf(-cu), e_p = __expf(cu), e_t = __expf(tot - cu);
                const float at = kkv[u] * __expf(cp);
                BM_(0)[t * BS + ci] = f2bf(at); FM(2)[t * MS + ci] = at;
                BM_(1)[t * BS + ci] = f2bf(kkv[u] * av[u] * e_m);
                BM_(2)[t * BS + ci] = f2bf(k2[u] * e_m);
                BM_(3)[t * BS + ci] = f2bf(rr[u] * e_p);
                bh[u] = kkv[u] * av[u] * e_t; kh[u] = k2[u] * e_t;
            }
            *(LAS u32x4*)(BM_(4) + ci * BS + tg8 * 8) = pack8(vx);
            *(LAS u32x4*)(BM_(5) + ci * BS + tg8 * 8) = pack8(bh);
            *(LAS u32x4*)(BM_(6) + ci * BS + tg8 * 8) = pack8(kh);
        }
        __syncthreads();
        {
            f32x4 x1[2], x2[2], x3[2], x4[2]; ZACC(x1); ZACC(x2); ZACC(x3); ZACC(x4);
            mmb(x1, BM_(0), BM_(2), mrow, nc0, q);
            mmb(x2, BM_(0), BM_(1), mrow, nc0, q);
            mmb(x3, BM_(3), BM_(1), mrow, nc0, q);
            mmb(x4, BM_(3), BM_(2), mrow, nc0, q);
#pragma unroll
            for (int i = 0; i < 2; ++i)
#pragma unroll
                for (int j = 0; j < 4; ++j) { const int r = mt * 16 + 4 * q + j, cc = nc0 + 16 * i;
                    BM_(7)[r * BS + cc] = f2bf(r > cc ? x1[i][j] : 0.f); FM(0)[r * MS + cc] = r > cc ? x2[i][j] : 0.f;
                    BM_(8)[r * BS + cc] = f2bf(r >= cc ? x3[i][j] : 0.f); BM_(9)[r * BS + cc] = f2bf(r >= cc ? x4[i][j] : 0.f); }
        }
        __syncthreads();
        {
            f32x4 x1[2]; ZACC(x1);
            mmb(x1, BM_(7), BM_(4), mrow, nc0, q);
#pragma unroll
            for (int i = 0; i < 2; ++i)
#pragma unroll
                for (int j = 0; j < 4; ++j) { const int r = mt * 16 + 4 * q + j, cc = nc0 + 16 * i; FM(1)[r * MS + cc] = x1[i][j]; }
            if (tid < 64) {
                const int blk = tid >> 4, col = tid & 15; const LAS float* L = FM(0) + (blk * 16) * MS + blk * 16;
                float x[16];
#pragma unroll
                for (int r = 0; r < 16; ++r) {
                    float a = (r == col) ? 1.f : 0.f;
#pragma unroll
                    for (int s2 = 0; s2 < r; ++s2) a -= L[r * MS + s2] * x[s2];
                    x[r] = a;
                }
#pragma unroll
                for (int r = 0; r < 16; ++r) DI[(blk * 16 + r) * 20 + col] = x[r];
            }
        }
        __syncthreads();
        {
            LAS float* RH = (w < 4) ? FM(2) : FM(1); const int cb = (w & 3) * 16;
            const LAS float* L = FM(0);
#pragma unroll
            for (int bi = 0; bi < 4; ++bi) {
                f32x4 t4;
#pragma unroll
                for (int j = 0; j < 4; ++j) t4[j] = RH[(bi * 16 + 4 * q + j) * MS + cb + l15];
#pragma unroll
                for (int bj = 0; bj < bi; ++bj)
#pragma unroll
                    for (int kk = 0; kk < 4; ++kk) {
                        const float a = -L[(bi * 16 + l15) * MS + bj * 16 + 4 * kk + q];
                        const float b = RH[(bj * 16 + 4 * kk + q) * MS + cb + l15];
                        t4 = __builtin_amdgcn_mfma_f32_16x16x4f32(a, b, t4, 0, 0, 0);
                    }
                const f32x4 dv = *(const LAS f32x4*)(DI + (bi * 16 + l15) * 20 + 4 * q);
                f32x4 o4 = (f32x4){0.f, 0.f, 0.f, 0.f};
#pragma unroll
                for (int j = 0; j < 4; ++j) o4 = __builtin_amdgcn_mfma_f32_16x16x4f32(dv[j], t4[j], o4, 0, 0, 0);
#pragma unroll
                for (int j = 0; j < 4; ++j) RH[(bi * 16 + 4 * q + j) * MS + cb + l15] = o4[j];
            }
            LAS bf16_t* WT = (w < 4) ? BM_(0) : BM_(1);
            float v8[8];
#pragma unroll
            for (int hh = 0; hh < 2; ++hh) {
#pragma unroll
                for (int i = 0; i < 8; ++i) v8[i] = RH[(q * 16 + hh * 8 + i) * MS + cb + l15];
                *(LAS u32x4*)(WT + (cb + l15) * BS + q * 16 + hh * 8) = pack8(v8);
            }
        }
        __syncthreads();
        {
            f32x4 xp[2], xa[2], xb[2]; ZACC(xp); ZACC(xa); ZACC(xb);
            mmb(xp, BM_(0), BM_(5), mrow, nc0, q);
            mmb(xa, BM_(1), BM_(5), mrow, nc0, q);
            mmb(xb, BM_(4), BM_(6), mrow, nc0, q);
            float* Pi = Pg + (size_t)item * 4096; float* Qi = Qg + (size_t)item * 4096;
#pragma unroll
            for (int i = 0; i < 2; ++i)
#pragma unroll
                for (int j = 0; j < 4; ++j) { const int r = mt * 16 + 4 * q + j, cc = nc0 + 16 * i;
                    Pi[r * 64 + cc] = (r == cc ? misc[r] : 0.f) - xp[i][j]; Qi[r * 64 + cc] = xb[i][j] - xa[i][j]; }
            f32x4 xr[2], ya[2], yb[2]; ZACC(xr); ZACC(ya); ZACC(yb);
            mmb(xr, BM_(8), BM_(0), mrow, nc0, q);
            mmb(ya, BM_(8), BM_(1), mrow, nc0, q);
            mmb(yb, BM_(9), BM_(4), mrow, nc0, q);
            bf16_t* Ri = Rcg + (size_t)item * 4096; bf16_t* Yi = Y0g + (size_t)item * 4096;
#pragma unroll
            for (int i = 0; i < 2; ++i)
#pragma unroll
                for (int j = 0; j < 4; ++j) { const int r = mt * 16 + 4 * q + j, cc = nc0 + 16 * i;
                    Ri[r * 64 + cc] = f2bf(bf2f(BM_(3)[r * BS + cc]) - xr[i][j]); Yi[r * 64 + cc] = f2bf(yb[i][j] - ya[i][j]); }
        }
        __syncthreads();
      }
    }
}

__device__ __forceinline__ void gmlp_phase(const Ctx& C) {
    const bf16_t* zg = (const bf16_t*)(C.ws + WS_ZG); const float* lnst = (const float*)(C.ws + WS_LNST);
    const float* ln_g = C.in[19]; const float* ln_b = C.in[20]; const float* w_s = C.in[21]; const float* b_s = C.in[22];
    bf16_t* ycat = (bf16_t*)(C.ws + WS_ACTA);
    constexpr int AS = 136;
    LAS bf16_t* Aw = (LAS bf16_t*)C.lds;
    LAS bf16_t* vT = (LAS bf16_t*)(C.lds + 128 * AS * 2);
    LAS float* st = (LAS float*)(C.lds + 192 * AS * 2);
    const int tid = C.tid, lane = C.lane, w = C.wave, q = lane >> 4, l15 = lane & 15;
    const int nslots = (C.G >= 8) ? (C.G / 8) : 1;
    const int h = C.bid & 7, slot = C.bid >> 3;
    if (C.G >= 8 && slot >= nslots) return;
    for (int hh = (C.G >= 8 ? h : 0); hh < (C.G >= 8 ? h + 1 : 8); ++hh) {
        __syncthreads();
        for (int e = tid; e < 128 * 64; e += NTHR) {
            const int t = e >> 6, s2 = (e & 63) * 2;
            const f32x2 wv = *(const f32x2*)(w_s + ((size_t)hh * 128 + t) * 128 + s2);
            const unsigned pk = pk2(s2 <= t ? wv.x : 0.f, (s2 + 1) <= t ? wv.y : 0.f);
            *(LAS unsigned*)(Aw + t * AS + s2) = pk;
        }
        for (int ch = (C.G >= 8 ? slot : C.bid); ch < 128; ch += (C.G >= 8 ? nslots : C.G)) {
            const int tok0 = ch * 128;
            const int dd = tid & 63;
            bf16_t vr[16], ur[4][4]; float bsr[4]; f32x4 sta = (f32x4){0.f, 0.f, 0.f, 0.f}, stb = sta, stc = sta, std_ = sta;
#pragma unroll
            for (int i = 0; i < 16; ++i) vr[i] = zg[(size_t)(tok0 + (tid >> 6) + 8 * i) * 1024 + 512 + hh * 64 + dd];
#pragma unroll
            for (int n = 0; n < 4; ++n)
#pragma unroll
                for (int j = 0; j < 4; ++j) ur[n][j] = zg[(size_t)(tok0 + w * 16 + 4 * q + j) * 1024 + hh * 64 + n * 16 + l15];
#pragma unroll
            for (int j = 0; j < 4; ++j) bsr[j] = b_s[hh * 128 + w * 16 + 4 * q + j];
            if (tid < 128) { const f32x4* p = (const f32x4*)(lnst + (size_t)(tok0 + tid) * 16); sta = p[0]; stb = p[1]; stc = p[2]; std_ = p[3]; }
            __syncthreads();
            if (tid < 128) {
                const float s1 = ((sta[0] + sta[2]) + (stb[0] + stb[2])) + ((stc[0] + stc[2]) + (std_[0] + std_[2]));
                const float s2 = ((sta[1] + sta[3]) + (stb[1] + stb[3])) + ((stc[1] + stc[3]) + (std_[1] + std_[3]));
                const float mean = s1 * (1.0f / 512.0f); const float var = fmaxf(s2 * (1.0f / 512.0f) - mean * mean, 0.f);
                st[tid] = mean; st[128 + tid] = 1.0f / sqrtf(var + 1e-5f);
            }
            __syncthreads();
            {
                const float gg = ln_g[hh * 64 + dd], bb = ln_b[hh * 64 + dd];
#pragma unroll
                for (int i = 0; i < 16; ++i) { const int s_ = (tid >> 6) + 8 * i;
                    vT[dd * AS + s_] = f2bf((bf2f(vr[i]) - st[s_]) * st[128 + s_] * gg + bb); }
            }
            __syncthreads();
            f32x4 acc[4];
#pragma unroll
            for (int n = 0; n < 4; ++n) acc[n] = (f32x4){0.f, 0.f, 0.f, 0.f};
            for (int ks = 0; ks < 4; ++ks) {
                if (ks * 32 > w * 16 + 15) break;
                const bf16x8 a = *(const LAS bf16x8*)(Aw + (w * 16 + l15) * AS + ks * 32 + q * 8);
#pragma unroll
                for (int n = 0; n < 4; ++n) {
                    const bf16x8 b = *(const LAS bf16x8*)(vT + (n * 16 + l15) * AS + ks * 32 + q * 8);
                    acc[n] = __builtin_amdgcn_mfma_f32_16x16x32_bf16(a, b, acc[n], 0, 0, 0);
                }
            }
#pragma unroll
            for (int n = 0; n < 4; ++n)
#pragma unroll
                for (int j = 0; j < 4; ++j) {
                    const int t = w * 16 + 4 * q + j, d = n * 16 + l15;
                    ycat[(size_t)(tok0 + t) * D_ + 512 + hh * 64 + d] = f2bf(bf2f(ur[n][j]) * (acc[n][j] + bsr[j]));
                }
        }
    }
    __syncthreads();
}

template <bool BT>
__device__ __forceinline__ void mm_lds(f32x4 (&acc)[2], const LAS float* A, const LAS float* B, int mrow, int nc0, int q) {
#pragma unroll
    for (int k0 = 0; k0 < 64; k0 += 16) {
        const f32x4 a = *(const LAS f32x4*)(A + mrow * MS + k0 + 4 * q);
        f32x4 b0, b1;
        if (BT) { b0 = *(const LAS f32x4*)(B + nc0 * MS + k0 + 4 * q); b1 = *(const LAS f32x4*)(B + (nc0 + 16) * MS + k0 + 4 * q); }
        else {
#pragma unroll
            for (int j = 0; j < 4; ++j) { b0[j] = B[(k0 + 4 * q + j) * MS + nc0]; b1[j] = B[(k0 + 4 * q + j) * MS + nc0 + 16]; }
        }
#pragma unroll
        for (int j = 0; j < 4; ++j) {
            acc[0] = __builtin_amdgcn_mfma_f32_16x16x4f32(a[j], b0[j], acc[0], 0, 0, 0);
            acc[1] = __builtin_amdgcn_mfma_f32_16x16x4f32(a[j], b1[j], acc[1], 0, 0, 0);
        }
    }
}
__device__ __forceinline__ void rwkv_phase_b1(const Ctx& C) {
    const float* Pg = (const float*)(C.ws + WS_P); const float* Qg = (const float*)(C.ws + WS_Q);
    float* Pc = (float*)(C.ws + WS_PC); float* Qc = (float*)(C.ws + WS_QC);
    const int w = C.wave;
    const int mt = w >> 1, nt0 = (w & 1) * 2;
    for (int item = C.bid; item < 8 * NGRP; item += C.G) {
        int tid = C.tid; asm volatile("" : "+v"(tid));
        const int lane = tid & 63, q = lane >> 4, l15 = lane & 15, mrow = mt * 16 + l15, nc0 = nt0 * 16 + l15;
        const int h = item & 7, g = item >> 3;
        const int e0 = tid, e1 = tid + NTHR;
        const int r0 = e0 >> 4, c0 = (e0 & 15) * 4, r1 = e1 >> 4, c1 = (e1 & 15) * 4;
        {
            const f32x4* P4 = (const f32x4*)(Pg + (size_t)((g * GCH) * 8 + h) * 4096); const f32x4* Q4 = (const f32x4*)(Qg + (size_t)((g * GCH) * 8 + h) * 4096);
            const f32x4* N4 = (const f32x4*)(Pg + (size_t)((g * GCH + 1) * 8 + h) * 4096);
            *(LAS f32x4*)(MAT(0) + r0 * MS + c0) = P4[e0]; *(LAS f32x4*)(MAT(0) + r1 * MS + c1) = P4[e1];
            *(LAS f32x4*)(MAT(1) + r0 * MS + c0) = Q4[e0]; *(LAS f32x4*)(MAT(1) + r1 * MS + c1) = Q4[e1];
            *(LAS f32x4*)(MAT(2) + r0 * MS + c0) = N4[e0]; *(LAS f32x4*)(MAT(2) + r1 * MS + c1) = N4[e1];
        }
        __syncthreads();
        for (int cc = 1; cc < GCH; ++cc) {
            const LAS float* Pb = MAT(2 + ((cc - 1) & 1)); LAS float* Pn = MAT(2 + (cc & 1));
            const float* Qi = Qg + (size_t)((g * GCH + cc) * 8 + h) * 4096;
            f32x4 n0 = (f32x4){0.f, 0.f, 0.f, 0.f}, n1 = n0;
            if (cc + 1 < GCH) { const f32x4* N4 = (const f32x4*)(Pg + (size_t)((g * GCH + cc + 1) * 8 + h) * 4096); n0 = N4[e0]; n1 = N4[e1]; }
            float qv[2][4];
#pragma unroll
            for (int i = 0; i < 2; ++i)
#pragma unroll
                for (int j = 0; j < 4; ++j) qv[i][j] = Qi[(mt * 16 + 4 * q + j) * 64 + nc0 + 16 * i];
            f32x4 xp[2], xq[2]; ZACC(xp); ZACC(xq);
            mm_lds<false>(xp, MAT(0), Pb, mrow, nc0, q);
            mm_lds<false>(xq, MAT(1), Pb, mrow, nc0, q);
            __syncthreads();
#pragma unroll
            for (int i = 0; i < 2; ++i)
#pragma unroll
                for (int j = 0; j < 4; ++j) { const int r = mt * 16 + 4 * q + j, c2 = nc0 + 16 * i;
                    MAT(0)[r * MS + c2] = xp[i][j]; MAT(1)[r * MS + c2] = xq[i][j] + qv[i][j]; }
            if (cc + 1 < GCH) { *(LAS f32x4*)(Pn + r0 * MS + c0) = n0; *(LAS f32x4*)(Pn + r1 * MS + c1) = n1; }
            __syncthreads();
        }
        {
            f32x4* P4 = (f32x4*)(Pc + (size_t)(h * NGRP + g) * 4096); f32x4* Q4 = (f32x4*)(Qc + (size_t)(h * NGRP + g) * 4096);
            P4[e0] = *(const LAS f32x4*)(MAT(0) + r0 * MS + c0); P4[e1] = *(const LAS f32x4*)(MAT(0) + r1 * MS + c1);
            Q4[e0] = *(const LAS f32x4*)(MAT(1) + r0 * MS + c0); Q4[e1] = *(const LAS f32x4*)(MAT(1) + r1 * MS + c1);
        }
        __syncthreads();
    }
}
__device__ __forceinline__ void rwkv_phase_b2(const Ctx& C) {
    const float* Pc = (const float*)(C.ws + WS_PC); const float* Qc = (const float*)(C.ws + WS_QC); float* Sg = (float*)(C.ws + WS_SG);
    const int tid = C.tid, lane = C.lane, w = C.wave, q = lane >> 4, l15 = lane & 15;
    for (int item = C.bid; item < 32; item += C.G) {
        const int h = item >> 2, rb = item & 3;
        for (int e = tid; e < 1024; e += NTHR) MAT(0)[(e >> 6) * MS + (e & 63)] = 0.f;
        float pv[4][16], qv[4][4];
        const size_t ob = (size_t)(h * NGRP) * 4096;
        const int poff = (4 * q) * 64 + w * 16 + l15, qoff = (rb * 16 + 4 * q) * 64 + w * 16 + l15;
        if (w < 4) {
#pragma unroll
            for (int s = 0; s < 4; ++s) {
#pragma unroll
                for (int i = 0; i < 16; ++i) pv[s][i] = Pc[ob + (size_t)s * 4096 + poff + ((i & 3) + 16 * (i >> 2)) * 64];
#pragma unroll
                for (int j = 0; j < 4; ++j) qv[s][j] = Qc[ob + (size_t)s * 4096 + qoff + j * 64];
            }
        }
        __syncthreads();
        for (int g0 = 0; g0 < NGRP; g0 += 4) {
#pragma unroll
            for (int s = 0; s < 4; ++s) {
                const int g = g0 + s; const size_t o = ob + (size_t)g * 4096;
                for (int e = tid; e < 1024; e += NTHR) Sg[o + (rb * 16 + (e >> 6)) * 64 + (e & 63)] = MAT(0)[(e >> 6) * MS + (e & 63)];
                f32x4 a0 = (f32x4){0.f, 0.f, 0.f, 0.f}, a1 = a0; float qc[4];
                if (w < 4) {
                    const LAS float* m0 = MAT(0);
#pragma unroll
                    for (int kb = 0; kb < 4; kb += 2) {
                        const f32x4 s0 = *(const LAS f32x4*)(m0 + l15 * MS + 16 * kb + 4 * q), s1 = *(const LAS f32x4*)(m0 + l15 * MS + 16 * (kb + 1) + 4 * q);
#pragma unroll
                        for (int j = 0; j < 4; ++j) {
                            a0 = __builtin_amdgcn_mfma_f32_16x16x4f32(s0[j], pv[s][4 * kb + j], a0, 0, 0, 0);
                            a1 = __builtin_amdgcn_mfma_f32_16x16x4f32(s1[j], pv[s][4 * (kb + 1) + j], a1, 0, 0, 0);
                        }
                    }
#pragma unroll
                    for (int j = 0; j < 4; ++j) qc[j] = qv[s][j];
                    if (g + 4 < NGRP) {
#pragma unroll
                        for (int i = 0; i < 16; ++i) pv[s][i] = Pc[o + 4 * 4096 + poff + ((i & 3) + 16 * (i >> 2)) * 64];
#pragma unroll
                        for (int j = 0; j < 4; ++j) qv[s][j] = Qc[o + 4 * 4096 + qoff + j * 64];
                    }
                }
                __syncthreads();
                if (w < 4) {
#pragma unroll
                    for (int j = 0; j < 4; ++j) { const int r = 4 * q + j, c2 = w * 16 + l15; MAT(0)[r * MS + c2] = a0[j] + a1[j] + qc[j]; }
                }
                __syncthreads();
            }
        }
    }
}
__device__ __forceinline__ void rwkv_phase_c(const Ctx& C) {
    const bf16_t* zr = (const bf16_t*)(C.ws + WS_ZR); const float* mu = C.in[8]; const float* gn_g = C.in[17]; const float* gn_b = C.in[18];
    const float* Pg = (const float*)(C.ws + WS_P); const float* Qg = (const float*)(C.ws + WS_Q); const bf16_t* Y0g = (const bf16_t*)(C.ws + WS_Y0);
    const bf16_t* Rcg = (const bf16_t*)(C.ws + WS_RC); const bf16_t* Gg = (const bf16_t*)(C.ws + WS_G); const float* bon = (const float*)(C.ws + WS_BON);
    const float* Sg = (const float*)(C.ws + WS_SG); bf16_t* ycat = (bf16_t*)(C.ws + WS_ACTA);
    LAS bf16_t* SH = (LAS bf16_t*)MAT(4); LAS bf16_t* SL = (LAS bf16_t*)MAT(5);
    const int w = C.wave;
    const int mt = w >> 1, nt0 = (w & 1) * 2;
    for (int item = C.bid; item < 8 * NGRP; item += C.G) {
        int tid = C.tid; asm volatile("" : "+v"(tid));
        const int lane = tid & 63, q = lane >> 4, l15 = lane & 15, mrow = mt * 16 + l15, nc0 = nt0 * 16 + l15;
        const int ci = tid & 63, tg8 = tid >> 6;
        const int h = item & 7, g = item >> 3;
        const int e0 = tid, e1 = tid + NTHR;
        const int r0 = e0 >> 4, c0 = (e0 & 15) * 4, r1 = e1 >> 4, c1 = (e1 & 15) * 4;
        const int rr8 = tid >> 3, cc8 = (tid & 7) * 8;
        {
            const f32x4* S4 = (const f32x4*)(Sg + (size_t)(h * NGRP + g) * 4096);
            const f32x4 sa = S4[e0], sb = S4[e1];
            *(LAS f32x4*)(MAT(0) + r0 * MS + c0) = sa; *(LAS f32x4*)(MAT(0) + r1 * MS + c1) = sb;
            { u32x2 hi; hi.x = pk2(sa[0], sa[1]); hi.y = pk2(sa[2], sa[3]); const f32x4 rs = sa - bflo4(hi.x, hi.y); u32x2 lo; lo.x = pk2(rs[0], rs[1]); lo.y = pk2(rs[2], rs[3]);
              *(LAS u32x2*)(SH + r0 * BS + c0) = hi; *(LAS u32x2*)(SL + r0 * BS + c0) = lo; }
            { u32x2 hi; hi.x = pk2(sb[0], sb[1]); hi.y = pk2(sb[2], sb[3]); const f32x4 rs = sb - bflo4(hi.x, hi.y); u32x2 lo; lo.x = pk2(rs[0], rs[1]); lo.y = pk2(rs[2], rs[3]);
              *(LAS u32x2*)(SH + r1 * BS + c1) = hi; *(LAS u32x2*)(SL + r1 * BS + c1) = lo; }
            const size_t io = (size_t)((g * GCH) * 8 + h) * 4096;
            const f32x4* P4 = (const f32x4*)(Pg + io);
            *(LAS f32x4*)(MAT(2) + r0 * MS + c0) = P4[e0]; *(LAS f32x4*)(MAT(2) + r1 * MS + c1) = P4[e1];
            *(LAS u32x4*)((LAS bf16_t*)MAT(6) + rr8 * BS + cc8) = ((const u32x4*)(Rcg + io))[tid];
        }
        const float gg = gn_g[h * 64 + ci], gb = gn_b[h * 64 + ci], muv = mu[1024 + h * 64 + ci];
        __syncthreads();
        for (int cc = 0; cc < GCH; ++cc) {
            const int c = g * GCH + cc, tok0 = c * 64; const size_t io = (size_t)(c * 8 + h) * 4096;
            const float* Qi = Qg + io; const bf16_t* Yi = Y0g + io;
            const LAS float* Pb = MAT(2 + (cc & 1)); const LAS bf16_t* Rb = (const LAS bf16_t*)MAT(6 + (cc & 1));
            f32x4 n0 = (f32x4){0.f, 0.f, 0.f, 0.f}, n1 = n0; u32x4 rn = (u32x4){0u, 0u, 0u, 0u};
            if (cc + 1 < GCH) { const f32x4* P4 = (const f32x4*)(Pg + io + 8 * 4096); n0 = P4[e0]; n1 = P4[e1]; rn = ((const u32x4*)(Rcg + io + 8 * 4096))[tid]; }
            float qv[2][4], yv[2][4];
#pragma unroll
            for (int i = 0; i < 2; ++i)
#pragma unroll
                for (int j = 0; j < 4; ++j) { const int r = mt * 16 + 4 * q + j, c2 = nc0 + 16 * i; qv[i][j] = Qi[r * 64 + c2]; yv[i][j] = bf2f(Yi[r * 64 + c2]); }
            float vv[8], bo[8], gt[8];
#pragma unroll
            for (int u = 0; u < 8; ++u) { const int tok = tok0 + tg8 * 8 + u; vv[u] = zshift(zr, tok, 1024 + h * 64 + ci, muv); bo[u] = bon[(size_t)tok * 8 + h]; gt[u] = bf2f(Gg[(size_t)tok * GWD_ + h * 64 + ci]); }
            f32x4 xy[2], xs[2]; ZACC(xy); ZACC(xs);
#pragma unroll
            for (int ks = 0; ks < 2; ++ks) {
                const bf16x8 a = *(const LAS bf16x8*)(Rb + mrow * BS + ks * 32 + q * 8);
                const bf16x8 h0 = *(const LAS bf16x8*)(SH + nc0 * BS + ks * 32 + q * 8), h1 = *(const LAS bf16x8*)(SH + (nc0 + 16) * BS + ks * 32 + q * 8);
                const bf16x8 l0 = *(const LAS bf16x8*)(SL + nc0 * BS + ks * 32 + q * 8), l1 = *(const LAS bf16x8*)(SL + (nc0 + 16) * BS + ks * 32 + q * 8);
                xy[0] = __builtin_amdgcn_mfma_f32_16x16x32_bf16(a, h0, xy[0], 0, 0, 0); xy[1] = __builtin_amdgcn_mfma_f32_16x16x32_bf16(a, h1, xy[1], 0, 0, 0);
                xy[0] = __builtin_amdgcn_mfma_f32_16x16x32_bf16(a, l0, xy[0], 0, 0, 0); xy[1] = __builtin_amdgcn_mfma_f32_16x16x32_bf16(a, l1, xy[1], 0, 0, 0);
            }
            mm_lds<false>(xs, MAT(0), Pb, mrow, nc0, q);
#pragma unroll
            for (int i = 0; i < 2; ++i)
#pragma unroll
                for (int j = 0; j < 4; ++j) { const int r = mt * 16 + 4 * q + j, c2 = nc0 + 16 * i; MAT(1)[r * MS + c2] = xy[i][j] + yv[i][j]; }
            __syncthreads();
#pragma unroll
            for (int i = 0; i < 2; ++i)
#pragma unroll
                for (int j = 0; j < 4; ++j) { const int r = mt * 16 + 4 * q + j, c2 = nc0 + 16 * i; const float sv = xs[i][j] + qv[i][j];
                    MAT(0)[r * MS + c2] = sv; const bf16_t hb = f2bf(sv); SH[r * BS + c2] = hb; SL[r * BS + c2] = f2bf(sv - bf2f(hb)); }
            if (cc + 1 < GCH) {
                LAS float* Pn = MAT(2 + ((cc + 1) & 1));
                *(LAS f32x4*)(Pn + r0 * MS + c0) = n0; *(LAS f32x4*)(Pn + r1 * MS + c1) = n1;
                *(LAS u32x4*)((LAS bf16_t*)MAT(6 + ((cc + 1) & 1)) + rr8 * BS + cc8) = rn;
            }
#pragma unroll
            for (int u = 0; u < 8; ++u) {
                const int t = tg8 * 8 + u, tok = tok0 + t;
                const float y = MAT(1)[t * MS + ci];
                const float mean = wave_sum(y) * (1.0f / 64.0f); const float dlt = y - mean;
                const float var = wave_sum(dlt * dlt) * (1.0f / 64.0f);
                const float yn = dlt * (1.0f / sqrtf(var + 64e-5f)) * gg + gb;
                ycat[(size_t)tok * D_ + h * 64 + ci] = f2bf((yn + bo[u] * vv[u]) * gt[u]);
            }
            __syncthreads();
        }
    }
}


__device__ __forceinline__ void phase0(const Ctx& C) {
    LAS float* scr = (LAS float*)(C.lds + C.wave * 8448);
    const int gw = C.bid * 8 + C.wave, NGW = C.G * 8, lane = C.lane;
    bf16_t* W13 = (bf16_t*)(C.ws + WS_W13A); bf16_t* W2 = (bf16_t*)(C.ws + WS_W2A); bf16_t* Win = (bf16_t*)(C.ws + WS_WIN); bf16_t* Wout = (bf16_t*)(C.ws + WS_WOUT);
    bf16_t* wdecT = (bf16_t*)(C.ws + WS_LORA); bf16_t* waaaT = wdecT + 512 * 64; bf16_t* wgateT = waaaT + 512 * 64;
    constexpr int I1 = 16 * 88, NIT = 3 * I1 + 64;
    for (int it = gw; it < NIT; it += NGW) {
        int r = it;
        if (r < 16) { transpose_item(C.in[10], 64, 512, nullptr, wdecT, 0, scr, r, lane); continue; } r -= 16;
        if (r < 16) { transpose_item(C.in[12], 64, 512, nullptr, waaaT, 0, scr, r, lane); continue; } r -= 16;
        if (r < 32) { transpose_item(C.in[13], 128, 512, nullptr, wgateT, 0, scr, r, lane); continue; } r -= 32;
        if (r < I1) { transpose_item(C.in[3], D_, FF_, C.in[2], W13, 1, scr, r, lane); continue; } r -= I1;
        if (r < I1) { transpose_item(C.in[4], D_, FF_, C.in[2], W13, 2, scr, r, lane); continue; } r -= I1;
        transpose_item(C.in[7], D_, FF_, C.in[6], Win, 0, scr, r, lane);
    }
    const float* x = C.in[0]; bf16_t* xb = (bf16_t*)(C.ws + WS_ACTA); float* ssq = (float*)(C.ws + WS_SSQA);
    for (int row = gw; row < T_; row += 4 * NGW) {
        f32x4 v[4][4];
#pragma unroll
        for (int r = 0; r < 4; ++r) { const int rw = (row + r * NGW < T_) ? row + r * NGW : row; const f32x4* xa = (const f32x4*)(x + (size_t)rw * D_) + lane;
#pragma unroll
            for (int j = 0; j < 4; ++j) v[r][j] = xa[64 * j]; }
#pragma unroll
        for (int r = 0; r < 4; ++r) {
            const int rw = row + r * NGW; const bool has = rw < T_;
            float s = 0.f; u32x2* oa = (u32x2*)(xb + (size_t)(has ? rw : row) * D_) + lane;
#pragma unroll
            for (int j = 0; j < 4; ++j) {
                s += (v[r][j][0] * v[r][j][0] + v[r][j][1] * v[r][j][1]) + (v[r][j][2] * v[r][j][2] + v[r][j][3] * v[r][j][3]);
                if (has) { u32x2 w; w.x = pk2(v[r][j][0], v[r][j][1]); w.y = pk2(v[r][j][2], v[r][j][3]); oa[64 * j] = w; }
            }
            s = wave_sum(s);
            if (has && lane < 16) ssq[(size_t)rw * 16 + lane] = lane == 0 ? s : 0.f;
        }
    }
}
__device__ __forceinline__ void convert_mid(const Ctx& C, int vbid, int vG) {
    LAS float* scr = (LAS float*)(C.lds + C.wave * 8448);
    const int gw = vbid * 8 + C.wave, NGW = vG * 8, lane = C.lane;
    bf16_t* W2 = (bf16_t*)(C.ws + WS_W2A); bf16_t* Win = (bf16_t*)(C.ws + WS_WIN); bf16_t* Wout = (bf16_t*)(C.ws + WS_WOUT);
    constexpr int I2 = 44 * 32, IO = 16 * 32, NIT = I2 + IO;
    for (int it = gw; it < NIT; it += NGW) {
        int r = it;
        if (r < I2) { transpose_item(C.in[5], FF_, D_, nullptr, W2, 0, scr, r, lane); continue; } r -= I2;
        transpose_item(C.in[23], D_, D_, nullptr, Wout, 0, scr, r, lane);
    }
}
__device__ __forceinline__ void convert_w13b(const Ctx& C) {
    LAS float* scr = (LAS float*)(C.lds + C.wave * 8448);
    const int gw = C.bid * 8 + C.wave, NGW = C.G * 8, lane = C.lane;
    bf16_t* W13 = (bf16_t*)(C.ws + WS_W13B);
    constexpr int I1 = 16 * 88;
    for (int it = gw; it < 2 * I1; it += NGW) {
        if (it < I1) transpose_item(C.in[25], D_, FF_, C.in[24], W13, 1, scr, it, lane);
        else transpose_item(C.in[26], D_, FF_, C.in[24], W13, 2, scr, it - I1, lane);
    }
}
__device__ __forceinline__ void convert_late(const Ctx& C, int vbid, int vG) {
    LAS float* scr = (LAS float*)(C.lds + C.wave * 8448);
    const int gw = vbid * 8 + C.wave, NGW = vG * 8, lane = C.lane;
    bf16_t* W2 = (bf16_t*)(C.ws + WS_W2B); bf16_t* Wg = (bf16_t*)(C.ws + WS_WG); bf16_t* Wple = (bf16_t*)(C.ws + WS_WPLE);
    constexpr int I2 = 44 * 32, IG = 16 * 32, IP = 4 * 32, NIT = I2 + IG + IP;
    for (int it = gw; it < NIT; it += NGW) {
        int r = it;
        if (r < I2) { transpose_item(C.in[27], FF_, D_, nullptr, W2, 0, scr, r, lane); continue; } r -= I2;
        if (r < IG) { transpose_item(C.in[29], D_, D_, C.in[28], Wg, 0, scr, r, lane); continue; } r -= IG;
        transpose_item(C.in[30], 256, D_, nullptr, Wple, 0, scr, r, lane);
    }
    const float* p = C.in[1]; bf16_t* pb = (bf16_t*)(C.ws + WS_PB);
    for (int row = gw; row < T_ / 4; row += NGW) {
        const f32x4* xr = (const f32x4*)(p + (size_t)row * 1024) + lane; u32x2* o8 = (u32x2*)(pb + (size_t)row * 1024) + lane;
#pragma unroll
        for (int j = 0; j < 4; ++j) { const f32x4 v = xr[64 * j]; u32x2 w; w.x = pk2(v[0], v[1]); w.y = pk2(v[2], v[3]); o8[64 * j] = w; }
    }
}
__device__ __forceinline__ void final_norm(const Ctx& C) {
    const int gw = C.bid * 8 + C.wave, NGW = C.G * 8, lane = C.lane;
    const float* ssq = (const float*)(C.ws + WS_SSQA); const float* gf = C.in[31]; const bf16_t* h4 = (const bf16_t*)(C.ws + WS_H4);
    f32x4 gv[4];
#pragma unroll
    for (int j = 0; j < 4; ++j) gv[j] = ((const f32x4*)gf)[lane + 64 * j];
    for (int row = gw; row < T_; row += NGW) {
        const float rs = row_rstd(ssq, row);
        f32x4* xr = (f32x4*)(C.out + (size_t)row * D_) + lane; const u32x2* hr = (const u32x2*)(h4 + (size_t)row * D_) + lane;
#pragma unroll
        for (int j = 0; j < 4; ++j) { const u32x2 hw = hr[64 * j];
            f32x4 v = (f32x4){__uint_as_float(hw.x << 16), __uint_as_float(hw.x & 0xffff0000u), __uint_as_float(hw.y << 16), __uint_as_float(hw.y & 0xffff0000u)};
            xr[64 * j] = v * rs * gv[j]; }
    }
}

#define XB_TMO      128
#define XB_XCNT(j)  (256  + 64 * (j))
#define XB_XSUB(j)  (1280 + 64 * (j))
#define XB_XGEN(j)  (2304 + 64 * (j))
#define XB_TOP      3328
#define XB_TOPGEN   3392
#define XCD_BAR_WORDS 3456
#define XB_SPIN_CAP (1u << 18)

__device__ __forceinline__ unsigned xb_ld(unsigned* p)              { return __hip_atomic_load(p, __ATOMIC_RELAXED, __HIP_MEMORY_SCOPE_AGENT); }
__device__ __forceinline__ unsigned xb_add(unsigned* p, unsigned v) { return __hip_atomic_fetch_add(p, v, __ATOMIC_RELAXED, __HIP_MEMORY_SCOPE_AGENT); }
__device__ __forceinline__ unsigned xb_xcc_id() { return (unsigned)__builtin_amdgcn_s_getreg((3 << 11) | 20) & 0xFu; }
#define XB_SPIN(cond, bar) do { unsigned _sp = 0; while (cond) { __builtin_amdgcn_s_sleep(1); \
    if ((++_sp & 255u) == 0u) { if (xb_ld(&(bar)[XB_TMO])) break; if (_sp > XB_SPIN_CAP) { atomicAdd(&(bar)[XB_TMO], 1u); break; } } } } while (0)
struct XcdBarrier {
    unsigned* bar; unsigned x;
    volatile LAS unsigned* st;
};

__device__ __forceinline__ XcdBarrier xcd_barrier_post(unsigned* bar, volatile LAS unsigned* st) {
    XcdBarrier b; b.bar = bar; b.x = xb_xcc_id(); b.st = st;
    if (threadIdx.x == 0) (void)xb_add(&bar[XB_XCNT(b.x)], 1u);
    return b;
}
__device__ __forceinline__ void xcd_barrier_complete(unsigned* bar, unsigned x, unsigned& nloc, unsigned& nx) {
    const unsigned G = gridDim.x * gridDim.y * gridDim.z;
    unsigned sum, cnt, mine, sp = 0u;
    for (;;) {
        sum = 0u; cnt = 0u; mine = 0u;
#pragma unroll
        for (unsigned j = 0; j < 16; ++j) { const unsigned c = xb_ld(&bar[XB_XCNT(j)]); sum += c; cnt += (c > 0u) ? 1u : 0u; mine = (j == x) ? c : mine; }
        if (sum == G) break;
        __builtin_amdgcn_s_sleep(1);
        if ((++sp & 255u) == 0u) { if (xb_ld(&bar[XB_TMO])) break; if (sp > XB_SPIN_CAP) { atomicAdd(&bar[XB_TMO], 1u); break; } }
    }
    nloc = mine > 0u ? mine : 1u; nx = cnt > 0u ? cnt : 1u;
}

__device__ __forceinline__ void xcd_barrier(const XcdBarrier& b) {
    asm volatile("s_waitcnt vmcnt(0)" ::: "memory");
    __syncthreads();
    if (threadIdx.x == 0) {
        unsigned* bar = b.bar;
        __builtin_amdgcn_s_waitcnt(0);
        unsigned nloc = b.st[0], nx = b.st[1];
        if (nloc == 0u) { xcd_barrier_complete(bar, b.x, nloc, nx); b.st[0] = nloc; b.st[1] = nx; }
        const unsigned old = xb_add(&bar[XB_XSUB(b.x)], 1u);
        const unsigned gen = old / nloc;
        if (old + 1u == (gen + 1u) * nloc) {
            __builtin_amdgcn_fence(__ATOMIC_RELEASE, "agent");
            asm volatile("s_waitcnt vmcnt(0)" ::: "memory");
            const unsigned og = xb_add(&bar[XB_TOP], 1u);
            const unsigned tg = og / nx;
            if (og + 1u == (tg + 1u) * nx) xb_add(&bar[XB_TOPGEN], 1u);
            else XB_SPIN(xb_ld(&bar[XB_TOPGEN]) == tg, bar);
            __builtin_amdgcn_fence(__ATOMIC_ACQUIRE, "agent");
            xb_add(&bar[XB_XGEN(b.x)], 1u);
            asm volatile("s_waitcnt vmcnt(0)" ::: "memory");
        } else {
            XB_SPIN(xb_ld(&bar[XB_XGEN(b.x)]) == gen, bar);
            __builtin_amdgcn_fence(__ATOMIC_ACQUIRE, "agent");
            asm volatile("s_waitcnt vmcnt(0)" ::: "memory");
        }
    }
    __syncthreads();
}

constexpr size_t WS_BAR = 255 * MiB;
constexpr int ST_OFF = LDS_BYTES - 16;

#ifndef X_RESID_BF16
#define X_RESID_BF16 1
#endif
#ifndef KEEP_LO1
#define KEEP_LO1 false
#endif
#ifndef KEEP_LO2
#define KEEP_LO2 false
#endif
#ifndef KEEP_LO3
#define KEEP_LO3 false
#endif
struct Args { const float* in[32]; float* out; unsigned char* ws; int ph_lo, ph_hi, flags, pad; };

__global__ void __launch_bounds__(NTHR, 2) fwd_kernel(Args args) {
    __builtin_assume(__builtin_amdgcn_workitem_id_y() == 0); __builtin_assume(__builtin_amdgcn_workitem_id_z() == 0);
    extern __shared__ __attribute__((aligned(16))) unsigned char lds_raw[];
    cg::grid_group grid = cg::this_grid();
    Ctx C;
    C.lds = (LAS unsigned char*)lds_raw; C.tid = threadIdx.x; C.lane = C.tid & 63; C.wave = __builtin_amdgcn_readfirstlane(C.tid >> 6);
    C.G = gridDim.x; C.bid = blockIdx.x; C.in = args.in; C.out = args.out; C.ws = args.ws;
    const int lo = args.ph_lo, hi = args.ph_hi;
    if (threadIdx.x < 4) ((LAS unsigned*)(C.lds + ST_OFF))[threadIdx.x] = 0u;
    __syncthreads();
    XcdBarrier xbar = xcd_barrier_post((unsigned*)(args.ws + WS_BAR), (volatile LAS unsigned*)(C.lds + ST_OFF));
    unsigned char* ws = args.ws;
    bf16_t* actA = (bf16_t*)(ws + WS_ACTA); bf16_t* actB = (bf16_t*)(ws + WS_ACTB); bf16_t* hid = (bf16_t*)(ws + WS_HID);
    float* ssqA = (float*)(ws + WS_SSQA); float* ssqB = (float*)(ws + WS_SSQB);
    bf16_t* hlo3 = (bf16_t*)(ws + 184 * MiB);
    bf16_t* hlo = (bf16_t*)args.out;
    bf16_t* hhi1 = hlo + (size_t)T_ * D_;
#define IN(k) (lo <= (k) && (k) < hi)
#define SEAM(k) do { if (IN(k) && IN((k) + 1)) xcd_barrier(xbar); } while (0)

    if (IN(0)) { phase0(C); } SEAM(0);
    if (IN(1)) {
        pg8::Gemm g{actA, (const bf16_t*)(ws + WS_W13A), T_, 2 * FF_, D_}; pg8::StaticOrder S; S.init(T_, 2 * FF_, C.G, C.bid);
        EpiSwiGLU E{hid, ssqA};
        pg8::gemm_phase<EpiSwiGLU, pg8::StaticOrder, true, true>(C.lds, g, S, E);
        { const int rem = S.nwg % C.G; __syncthreads(); if (rem == 0) convert_mid(C, C.bid, C.G); else if (C.bid >= rem) convert_mid(C, C.bid - rem, C.G - rem); }
    } SEAM(1);
    if (IN(2)) {
        pg8::Gemm g{hid, (const bf16_t*)(ws + WS_W2A), T_, D_, FF_}; pg8::StaticOrder S; S.init(T_, D_, C.G, C.bid);
#if X_RESID_BF16
        EpiResid<1, false, KEEP_LO1> E{nullptr, actA, nullptr, hlo, hhi1, ssqB, 0.5f};
        pg8::gemm_phase<EpiResid<1, false, KEEP_LO1>, pg8::StaticOrder, false, true>(C.lds, g, S, E);
#else
        EpiResid<0, false, KEEP_LO1> E{args.in[0], nullptr, nullptr, hlo, hhi1, ssqB, 0.5f};
        pg8::gemm_phase<EpiResid<0, false, KEEP_LO1>, pg8::StaticOrder, false, true>(C.lds, g, S, E);
#endif
    } SEAM(2);
    if (IN(3)) {
        pg8::Gemm g{hhi1, (const bf16_t*)(ws + WS_WIN), T_, FF_, D_}; pg8::StaticOrder S; S.init(T_, FF_, C.G, C.bid);
        EpiZ E{(bf16_t*)(ws + WS_ZR), (bf16_t*)(ws + WS_ZG), ssqB, (float*)(ws + WS_LNST)};
        pg8::gemm_phase<EpiZ, pg8::StaticOrder, true, true>(C.lds, g, S, E);
    } SEAM(3);
    if (IN(4)) { rwkv_phase_a(C); } SEAM(4);
    if (IN(5)) { rwkv_phase_b1(C); } SEAM(5);
    if (IN(6)) {
        if (C.G >= 64) { if (C.bid < 32) rwkv_phase_b2(C); else { Ctx C2 = C; C2.bid = C.bid - 32; C2.G = C.G - 32; gmlp_phase(C2); } }
        else { rwkv_phase_b2(C); __syncthreads(); gmlp_phase(C); }
    } SEAM(6);
    if (IN(7)) { rwkv_phase_c(C); } SEAM(7);
    if (IN(8)) {
        convert_w13b(C); __syncthreads();
        pg8::Gemm g{actA, (const bf16_t*)(ws + WS_WOUT), T_, D_, D_}; pg8::StaticOrder S; S.init(T_, D_, C.G, C.bid);
        EpiResid<1, KEEP_LO1, KEEP_LO2> E{nullptr, hhi1, hlo, hlo, actB, ssqA, 1.0f};
        pg8::gemm_phase<EpiResid<1, KEEP_LO1, KEEP_LO2>, pg8::StaticOrder, false, true>(C.lds, g, S, E);
    } SEAM(8);
    if (IN(9)) {
        pg8::Gemm g{actB, (const bf16_t*)(ws + WS_W13B), T_, 2 * FF_, D_}; pg8::StaticOrder S; S.init(T_, 2 * FF_, C.G, C.bid);
        EpiSwiGLU E{hid, ssqA};
        pg8::gemm_phase<EpiSwiGLU, pg8::StaticOrder, true, true>(C.lds, g, S, E);
        { const int rem = S.nwg % C.G; __syncthreads(); if (rem == 0) convert_late(C, C.bid, C.G); else if (C.bid >= rem) convert_late(C, C.bid - rem, C.G - rem); }
    } SEAM(9);
    if (IN(10)) {
        pg8::Gemm g{hid, (const bf16_t*)(ws + WS_W2B), T_, D_, FF_}; pg8::StaticOrder S; S.init(T_, D_, C.G, C.bid);
        EpiResid<1, KEEP_LO2, KEEP_LO3> E{nullptr, actB, hlo, hlo3, actA, ssqB, 0.5f};
        pg8::gemm_phase<EpiResid<1, KEEP_LO2, KEEP_LO3>, pg8::StaticOrder, false, true>(C.lds, g, S, E);
    } SEAM(10);
    const bool fuse_final = (64 * 4 == C.G);
    if (IN(11)) {
        { pg8::Gemm g{(const bf16_t*)(ws + WS_PB), (const bf16_t*)(ws + WS_WPLE), T_, D_, 256}; pg8::StaticOrder S; S.init(T_, D_, C.G, C.bid);
          EpiPE E{(bf16_t*)(ws + WS_PE)};
          pg8::gemm_phase<EpiPE, pg8::StaticOrder, false, true>(C.lds, g, S, E); }
        __syncthreads();
        if (fuse_final) {
          pg8::Gemm g{actA, (const bf16_t*)(ws + WS_WG), T_, D_, D_}; pg8::StaticOrder S; S.init(T_, D_, C.G, C.bid);
          EpiGateFinal E{(const bf16_t*)(ws + WS_PE), actA, KEEP_LO3 ? hlo3 : nullptr, args.out, args.in[31], ssqB, ssqA, (unsigned*)(ws + WS_BAR + 16384)};
          pg8::gemm_phase<EpiGateFinal, pg8::StaticOrder, false, true>(C.lds, g, S, E);
        } else {
          pg8::Gemm g{actA, (const bf16_t*)(ws + WS_WG), T_, D_, D_}; pg8::StaticOrder S; S.init(T_, D_, C.G, C.bid);
          EpiGate E{(const bf16_t*)(ws + WS_PE), actA, KEEP_LO3 ? hlo3 : nullptr, (bf16_t*)(ws + WS_H4), ssqB, ssqA};
          pg8::gemm_phase<EpiGate, pg8::StaticOrder, false, true>(C.lds, g, S, E);
        }
    }
    if (!fuse_final) SEAM(11);
    if (IN(12) && !fuse_final) { final_norm(C); }
    if (hi > 64) grid.sync();
#undef IN
#undef SEAM
}

extern "C" void kernel_launch(void* const* d_in, const int* in_sizes, int n_in, void* d_out, int out_size, void* d_ws, size_t ws_size, hipStream_t stream) {
    static int grid = 0;
    if (grid == 0) {
        int dev = 0, cus = 0, per_cu = 0;
        hipGetDevice(&dev);
        hipDeviceGetAttribute(&cus, hipDeviceAttributeMultiprocessorCount, dev);
        if (hipFuncSetAttribute((const void*)fwd_kernel, hipFuncAttributeMaxDynamicSharedMemorySize, LDS_BYTES) != hipSuccess) fprintf(stderr, "hipFuncSetAttribute failed\n");
        hipOccupancyMaxActiveBlocksPerMultiprocessor(&per_cu, (const void*)fwd_kernel, NTHR, LDS_BYTES);
        if (per_cu < 1) { fprintf(stderr, "occupancy query says %d blocks/CU\n", per_cu); per_cu = 1; }
        if (per_cu > 1) per_cu = 1;
        grid = cus * per_cu;
        (void)hipGetLastError();
        if (ws_size < 254 * MiB) fprintf(stderr, "workspace too small: %zu\n", ws_size);
    }
    (void)hipMemsetAsync((char*)d_ws + WS_BAR, 0, 32768, stream);
    Args a{};
    for (int i = 0; i < 32; ++i) a.in[i] = (const float*)d_in[i];
    a.out = (float*)d_out; a.ws = (unsigned char*)d_ws;
#if defined(MK_MULTI)
    for (int ph = 0; ph < 13; ++ph) { a.ph_lo = ph; a.ph_hi = ph + 1; hipLaunchKernelGGL(fwd_kernel, dim3(grid), dim3(NTHR), LDS_BYTES, stream, a); }
#else
    a.ph_lo = 0; a.ph_hi = 13;
    void* kargs[] = {&a};
    hipError_t e = hipLaunchCooperativeKernel((const void*)fwd_kernel, dim3(grid), dim3(NTHR), kargs, LDS_BYTES, stream);
    if (e != hipSuccess) fprintf(stderr, "cooperative launch failed: %s (grid %d)\n", hipGetErrorString(e), grid);
#if defined(PROBE_PHASES)
    a.flags = PROBE_FLAGS; for (int ph = 0; ph < 13; ++ph) if ((PROBE_PHASES >> ph) & 1) { a.ph_lo = ph; a.ph_hi = ph + 1; hipLaunchKernelGGL(fwd_kernel, dim3(grid), dim3(NTHR), LDS_BYTES, stream, a); }
#endif
#endif
}
```
